# Optimizing an MI355X kernel written in HIP

```python
import math
import jax, jax.numpy as jnp
from jax import lax
import numpy as np

D_MODEL = 1024
BATCH = 8
SEQ = 2048
DEPTH = 2

CHUNK = 64
Q_BLOCK = 128
N_MIXERS = 2
N_HEADS = 8
QK_DIM = 64
V_DIM = 2 * QK_DIM
QKV_COLS = N_HEADS * (4 * QK_DIM + V_DIM)
CONV_WIDTH = 3
D_FF = 2816
NORM_EPS = 1e-6
SUBLN_EPS = 1e-5
N_ATTN_LAYERS = (DEPTH + 1) // 2
N_CONV_LAYERS = DEPTH // 2

kernel_name = "chunk_causal_diffattn_shortconv_hybrid"


def rms_norm(x, g, eps=NORM_EPS):
    xf = x.astype(jnp.float32)
    y = xf * lax.rsqrt(jnp.mean(xf * xf, axis=-1, keepdims=True) + eps)
    return (y * g.astype(jnp.float32)).astype(x.dtype)


def causal_dwconv(x, w):
    k = w.shape[0]
    s = x.shape[1]
    xp = jnp.pad(x, ((0, 0), (k - 1, 0), (0, 0)))
    out = xp[:, 0:s, :] * w[0]
    for j in range(1, k):
        out = out + xp[:, j:j + s, :] * w[j]
    return out


def alibi_slopes(n_heads):
    return jnp.exp2(-8.0 * jnp.arange(1, n_heads + 1, dtype=jnp.float32) / n_heads)


def diff_attention(h, w_qkv, w_o, lq1, lk1, lq2, lk2, subln_g, lambda_init):
    b, s, _ = h.shape
    proj = h @ w_qkv
    qk_w = N_HEADS * QK_DIM
    q1, q2, k1, k2, v = jnp.split(proj, [qk_w, 2 * qk_w, 3 * qk_w, 4 * qk_w], axis=-1)
    scale = QK_DIM ** -0.5
    q1 = q1.reshape(b, s, N_HEADS, QK_DIM) * scale
    q2 = q2.reshape(b, s, N_HEADS, QK_DIM) * scale
    k1 = k1.reshape(b, s, N_HEADS, QK_DIM)
    k2 = k2.reshape(b, s, N_HEADS, QK_DIM)
    v = v.reshape(b, s, N_HEADS, V_DIM)
    lam = (jnp.exp(jnp.sum(lq1.astype(jnp.float32) * lk1.astype(jnp.float32)))
           - jnp.exp(jnp.sum(lq2.astype(jnp.float32) * lk2.astype(jnp.float32)))
           + lambda_init)
    slopes = alibi_slopes(N_HEADS)
    pos = jnp.arange(s, dtype=jnp.int32)
    outs = []
    for qb in range(s // Q_BLOCK):
        q0 = qb * Q_BLOCK
        kend = q0 + Q_BLOCK
        qp = pos[q0:kend]
        kp = pos[:kend]
        allowed = (kp[None, :] // CHUNK) <= (qp[:, None] // CHUNK)
        dist = jnp.abs(qp[:, None] - kp[None, :]).astype(jnp.float32)
        bias = jnp.where(allowed[None], -slopes[:, None, None] * dist[None], -jnp.inf)
        s1 = jnp.einsum('bqhd,bkhd->bhqk', q1[:, q0:kend], k1[:, :kend]).astype(jnp.float32) + bias
        s2 = jnp.einsum('bqhd,bkhd->bhqk', q2[:, q0:kend], k2[:, :kend]).astype(jnp.float32) + bias
        a = jax.nn.softmax(s1, axis=-1) - lam * jax.nn.softmax(s2, axis=-1)
        outs.append(jnp.einsum('bhqk,bkhe->bqhe', a.astype(v.dtype), v[:, :kend]))
    o = jnp.concatenate(outs, axis=1)
    o = rms_norm(o, subln_g, SUBLN_EPS) * (1.0 - lambda_init)
    return o.reshape(b, s, N_HEADS * V_DIM) @ w_o


def short_conv_mixer(h, w_in, conv_w, w_out):
    b_gate, c_gate, hv = jnp.split(h @ w_in, 3, axis=-1)
    return (b_gate * causal_dwconv(c_gate * hv, conv_w)) @ w_out


def conv_glu_ffn(h, w_up, conv_w, w_down):
    u = causal_dwconv(h @ w_up, conv_w)
    gate, val = jnp.split(u, 2, axis=-1)
    return (jax.nn.silu(gate) * val) @ w_down


def setup_inputs(seed: int = 0) -> dict:
    key = jax.random.key(seed)
    ks = jax.random.split(key, 16)
    f32 = jnp.float32
    d = D_MODEL

    def nrm(k, shape, scale):
        return jax.random.normal(k, shape, f32) * scale

    return {
        "x": jax.random.normal(ks[0], (BATCH, SEQ, d), f32),
        "norm_g": 1.0 + nrm(ks[1], (DEPTH, 4, d), 0.05),
        "attn_w_qkv": nrm(ks[2], (N_ATTN_LAYERS, d, QKV_COLS), d ** -0.5),
        "attn_w_o": nrm(ks[3], (N_ATTN_LAYERS, N_HEADS * V_DIM, d), (N_HEADS * V_DIM) ** -0.5),
        "attn_lambda_q1": nrm(ks[4], (N_ATTN_LAYERS, QK_DIM), 0.1),
        "attn_lambda_k1": nrm(ks[5], (N_ATTN_LAYERS, QK_DIM), 0.1),
        "attn_lambda_q2": nrm(ks[6], (N_ATTN_LAYERS, QK_DIM), 0.1),
        "attn_lambda_k2": nrm(ks[7], (N_ATTN_LAYERS, QK_DIM), 0.1),
        "attn_subln_g": 1.0 + nrm(ks[8], (N_ATTN_LAYERS, V_DIM), 0.05),
        "conv_w_in": nrm(ks[9], (N_CONV_LAYERS, d, 3 * d), d ** -0.5),
        "conv_w": nrm(ks[10], (N_CONV_LAYERS, CONV_WIDTH, d), CONV_WIDTH ** -0.5),
        "conv_w_out": nrm(ks[11], (N_CONV_LAYERS, d, d), d ** -0.5),
        "ffn_w_up": nrm(ks[12], (DEPTH, d, 2 * D_FF), d ** -0.5),
        "ffn_conv_w": nrm(ks[13], (DEPTH, CONV_WIDTH, 2 * D_FF), CONV_WIDTH ** -0.5),
        "ffn_w_down": nrm(ks[14], (DEPTH, D_FF, d), D_FF ** -0.5),
    }


def reference(x, norm_g, attn_w_qkv, attn_w_o, attn_lambda_q1, attn_lambda_k1,
              attn_lambda_q2, attn_lambda_k2, attn_subln_g, conv_w_in, conv_w,
              conv_w_out, ffn_w_up, ffn_conv_w, ffn_w_down):
    for layer in range(DEPTH):
        g = norm_g[layer]
        h = rms_norm(x, g[0])
        i = layer // N_MIXERS
        if layer % N_MIXERS == 0:
            lambda_init = 0.8 - 0.6 * math.exp(-0.3 * layer)
            m = diff_attention(h, attn_w_qkv[i], attn_w_o[i], attn_lambda_q1[i],
                               attn_lambda_k1[i], attn_lambda_q2[i], attn_lambda_k2[i],
                               attn_subln_g[i], lambda_init)
        else:
            m = short_conv_mixer(h, conv_w_in[i], conv_w[i], conv_w_out[i])
        x = x + rms_norm(m, g[1])
        h = rms_norm(x, g[2])
        x = x + rms_norm(conv_glu_ffn(h, ffn_w_up[layer], ffn_conv_w[layer], ffn_w_down[layer]), g[3])
    return x
```

```cpp
#include <hip/hip_runtime.h>
#include <hip/hip_cooperative_groups.h>
#include <cstdio>
#include <cstdint>
#include <cmath>
namespace cg = cooperative_groups;
namespace pg8 {
#define PG8_LAS __attribute__((address_space(3)))
typedef unsigned short bf16_t;
typedef short bf16x8 __attribute__((ext_vector_type(8)));
typedef float f32x4 __attribute__((ext_vector_type(4)));
typedef unsigned u32x4 __attribute__((ext_vector_type(4)));
constexpr int BM = 256, BK = 64, HALF = 128, HTB = HALF * BK * 2  , STAGE_BYTES = 8 * HTB, NXCD = 8, WGM = 8;

__host__ __device__ __forceinline__ int lds_byte(int r, int c) { const int st = (r >> 4) * 2 + (c >> 5), rr = r & 15, cc = c & 31, ob = rr * 64 + cc * 2; return st * 1024 + (ob ^ (((ob >> 9) & 1) << 5)); }
__host__ __device__ __forceinline__ void stage_rc(int b, int& R, int& C) { const int st = b / 1024, sb = b % 1024, swz = sb ^ (((sb >> 9) & 1) << 5); R = (st >> 1) * 16 + swz / 64; C = (st & 1) * 32 + (swz % 64) / 2; }
__host__ __device__ __forceinline__ int perm32(int rho) { const int n = rho >> 4, i = rho & 15; return 8 * (i >> 2) + 4 * n + (i & 3); }

struct Unit { int pm, pn; };
struct Gemm { const bf16_t* A; const bf16_t* Bt; int M, N, K; };

struct StaticOrder {
    int nM, nN, nwg, G, c;
    __host__ __device__ void init(int M, int N, int G_, int c_) { nM = M / BM; nN = N / BM; nwg = nM * nN; G = G_; c = c_; }
    __host__ __device__ bool next(int i, Unit& u) const {
        const long L = (long)i * G + c; if (L >= nwg) return false;
        int wgid = (int)L; { const int q = nwg / NXCD, r = nwg % NXCD, xcd = wgid % NXCD, off = wgid / NXCD; wgid = (xcd < r ? xcd * (q + 1) : r * (q + 1) + (xcd - r) * q) + off; }
        const int nig = WGM * nN, gid = wgid / nig, fm = gid * WGM, gsz = (nM - fm) < WGM ? (nM - fm) : WGM;
        u.pm = fm + ((wgid % nig) % gsz); u.pn = (wgid % nig) / gsz; return true;
    }
    __device__ __forceinline__ void a_ready(const Unit&) const {}
    __device__ __forceinline__ void done(const Unit&) const {}
};

__device__ __forceinline__ unsigned cvt_pk_bf16(float lo, float hi) { unsigned r; asm volatile("v_cvt_pk_bf16_f32 %0, %1, %2" : "=v"(r) : "v"(lo), "v"(hi)); return r; }
struct EpiBf16 {
    static constexpr bool PERM = true, AFTER_DRAIN = false;
    bf16_t* O; int ldc; int scale_cols; float scale0;
    __device__ __forceinline__ void operator()(const f32x4 (&acc)[2][2][4][2], const Unit& u, int wr, int wc, int fr, int fq) const {
        const int row0 = u.pm * BM + wr * 64 + fr; const int colt = u.pn * BM;
        const float sc = (colt < scale_cols) ? scale0 : 1.f;
        const int col0 = colt + wc * 32 + 8 * fq;
#pragma unroll
        for (int ai = 0; ai < 2; ++ai)
#pragma unroll
            for (int m = 0; m < 4; ++m) { bf16_t* rowp = O + (size_t)(row0 + ai * HALF + m * 16) * ldc + col0;
#pragma unroll
                for (int bj = 0; bj < 2; ++bj) { f32x4 v0 = acc[ai][bj][m][0] * sc, v1 = acc[ai][bj][m][1] * sc;
                    u32x4 w; w.x = cvt_pk_bf16(v0[0], v0[1]); w.y = cvt_pk_bf16(v0[2], v0[3]); w.z = cvt_pk_bf16(v1[0], v1[1]); w.w = cvt_pk_bf16(v1[2], v1[3]);
                    *(u32x4*)(rowp + bj * HALF) = w; } }
    }
};
struct EpiF32 {
    static constexpr bool PERM = true, AFTER_DRAIN = false;
    float* O; int ldc;
    __device__ __forceinline__ void operator()(const f32x4 (&acc)[2][2][4][2], const Unit& u, int wr, int wc, int fr, int fq) const {
        const int row0 = u.pm * BM + wr * 64 + fr; const int col0 = u.pn * BM + wc * 32 + 8 * fq;
#pragma unroll
        for (int ai = 0; ai < 2; ++ai)
#pragma unroll
            for (int m = 0; m < 4; ++m) { float* rowp = O + (size_t)(row0 + ai * HALF + m * 16) * ldc + col0;
#pragma unroll
                for (int bj = 0; bj < 2; ++bj) { *(f32x4*)(rowp + bj * HALF) = acc[ai][bj][m][0]; *(f32x4*)(rowp + bj * HALF + 4) = acc[ai][bj][m][1]; } }
    }
};

template <class Epi, class Sched, bool ALIGN_EPI = false, bool SP2 = false>
__device__ __forceinline__ void gemm_phase(PG8_LAS unsigned char* lds, const Gemm g, const Sched& S, const Epi& E) {
    const int tid = threadIdx.x, wid = __builtin_amdgcn_readfirstlane(tid >> 6), lane = tid & 63, wr = wid >> 2, wc = wid & 3, fr = lane & 15, fq = lane >> 4;
    const int K = g.K, nt = K / BK;
    unsigned voffA[2], voffB[2];
#pragma unroll
    for (int i = 0; i < 2; ++i) { int R, C; stage_rc(tid * 16 + i * 8192, R, C); const int Rb = Epi::PERM ? ((R & ~31) + perm32(R & 31)) : R;
        voffA[i] = (unsigned)(R * K + C) * 2u; voffB[i] = (unsigned)(Rb * K + C) * 2u; }
    const size_t kstep = (size_t)(BK * 2);
    const size_t hstep = (size_t)HALF * K * 2;
    const size_t tstep = 2 * hstep;
    const unsigned ldsw = (unsigned)wid * 1024u;
    const int aoff = lds_byte(wr * 64 + fr, fq * 8), boff = lds_byte(wc * 32 + fr, fq * 8);
#define PG8_SA(b, h) (((b) * 2 + (h)) * HTB)
#define PG8_SB(b, h) ((4 + (b) * 2 + (h)) * HTB)
#define PG8_STAGE(bufoff, gbase, voff) do { _Pragma("unroll") for (int _i = 0; _i < 2; ++_i) \
        __builtin_amdgcn_global_load_lds((const unsigned*)((const char*)(gbase) + (voff)[_i]), (PG8_LAS unsigned*)(lds + (bufoff) + ldsw + _i * 8192), 16, 0, 0); } while (0)
#define PG8_LDA(dst, b, h) do { _Pragma("unroll") for (int m = 0; m < 4; ++m) _Pragma("unroll") for (int k = 0; k < 2; ++k) dst[m][k] = *(const PG8_LAS bf16x8*)(lds + PG8_SA(b, h) + aoff + m * 2048 + k * 1024); } while (0)
#define PG8_LDB(dst, b, h) do { _Pragma("unroll") for (int n = 0; n < 2; ++n) _Pragma("unroll") for (int k = 0; k < 2; ++k) dst[n][k] = *(const PG8_LAS bf16x8*)(lds + PG8_SB(b, h) + boff + n * 2048 + k * 1024); } while (0)
#define PG8_MMA(ai, bj, At, Bt) do { __builtin_amdgcn_s_setprio(1); _Pragma("unroll") for (int m = 0; m < 4; ++m) _Pragma("unroll") for (int n = 0; n < 2; ++n) _Pragma("unroll") for (int k = 0; k < 2; ++k) \
        acc[ai][bj][m][n] = __builtin_amdgcn_mfma_f32_16x16x32_bf16(Bt[n][k], At[m][k], acc[ai][bj][m][n], 0, 0, 0); __builtin_amdgcn_s_setprio(0); } while (0)
#define PG8_WAIT_V(n) asm volatile("s_waitcnt vmcnt(" #n ")" ::: "memory")
#define PG8_WAIT_L(n) asm volatile("s_waitcnt lgkmcnt(" #n ")" ::: "memory")
#define PG8_BAR __builtin_amdgcn_s_barrier()
#define PG8_SCHED __builtin_amdgcn_sched_barrier(0)
    Unit cur, nxt; int ui = 0;
    if (!S.next(0, cur)) return;
    f32x4 acc[2][2][4][2];
#pragma unroll
    for (int a = 0; a < 2; ++a)
#pragma unroll
        for (int b = 0; b < 2; ++b)
#pragma unroll
            for (int m = 0; m < 4; ++m)
#pragma unroll
                for (int n = 0; n < 2; ++n) acc[a][b][m][n] = (f32x4){0.f, 0.f, 0.f, 0.f};
    bf16x8 At[4][2], B0[2][2], B1[2][2];
    const char* cA = (const char*)g.A + (size_t)cur.pm * tstep; const char* cB = (const char*)g.Bt + (size_t)cur.pn * tstep;
    S.a_ready(cur);
    if constexpr (SP2) {
        PG8_STAGE(PG8_SB(0, 0), cB, voffB); PG8_STAGE(PG8_SB(0, 1), cB + hstep, voffB); PG8_STAGE(PG8_SA(0, 0), cA, voffA); PG8_STAGE(PG8_SA(0, 1), cA + hstep, voffA);
        if (wr == 1) PG8_BAR;
        PG8_WAIT_V(2); PG8_BAR;
        PG8_STAGE(PG8_SB(1, 0), cB + kstep, voffB); PG8_STAGE(PG8_SA(1, 0), cA + kstep, voffA); PG8_STAGE(PG8_SB(1, 1), cB + hstep + kstep, voffB);
        PG8_WAIT_V(6); PG8_BAR;
    } else {
        PG8_STAGE(PG8_SB(0, 0), cB, voffB); PG8_STAGE(PG8_SA(0, 0), cA, voffA); PG8_STAGE(PG8_SB(0, 1), cB + hstep, voffB); PG8_STAGE(PG8_SA(0, 1), cA + hstep, voffA);
        if (wr == 1) PG8_BAR;
        PG8_WAIT_V(4); PG8_BAR;
        PG8_STAGE(PG8_SB(1, 0), cB + kstep, voffB); PG8_STAGE(PG8_SA(1, 0), cA + kstep, voffA); PG8_STAGE(PG8_SB(1, 1), cB + hstep + kstep, voffB);
        PG8_WAIT_V(6); PG8_BAR;
    }
    for (;;) {
        const bool has_next = S.next(ui + 1, nxt);
        const char* nA = has_next ? (const char*)g.A + (size_t)nxt.pm * tstep : cA; const char* nB = has_next ? (const char*)g.Bt + (size_t)nxt.pn * tstep : cB;
        for (int t = 0; t < nt; t += 2) {
            const bool last = (t == nt - 2);
            const char* a1 = cA + (size_t)(t + 1) * kstep;
            const char* a2 = last ? nA : cA + (size_t)(t + 2) * kstep; const char* b2 = last ? nB : cB + (size_t)(t + 2) * kstep;
            const char* a3 = a2 + kstep; const char* b3 = b2 + kstep;
            if (last && has_next) S.a_ready(nxt);
            if constexpr (SP2) {
            PG8_LDB(B0, 0, 0); PG8_LDB(B1, 0, 1); PG8_SCHED; PG8_LDA(At, 0, 0); PG8_STAGE(PG8_SA(1, 1), a1 + hstep, voffA);
            PG8_WAIT_V(8); PG8_WAIT_L(0); PG8_BAR; PG8_MMA(0, 0, At, B0); PG8_MMA(0, 1, At, B1); PG8_BAR; PG8_SCHED;
            PG8_LDA(At, 0, 1); PG8_STAGE(PG8_SB(0, 0), b2, voffB); PG8_STAGE(PG8_SB(0, 1), b2 + hstep, voffB); PG8_STAGE(PG8_SA(0, 0), a2, voffA);
            PG8_WAIT_V(8); PG8_WAIT_L(0); PG8_BAR; PG8_MMA(1, 0, At, B0); PG8_MMA(1, 1, At, B1); PG8_BAR; PG8_SCHED;
            PG8_LDB(B0, 1, 0); PG8_LDB(B1, 1, 1); PG8_SCHED; PG8_LDA(At, 1, 0); PG8_STAGE(PG8_SA(0, 1), a2 + hstep, voffA);
            PG8_WAIT_V(8); PG8_WAIT_L(0); PG8_BAR; PG8_MMA(0, 0, At, B0); PG8_MMA(0, 1, At, B1); PG8_BAR; PG8_SCHED;
            PG8_LDA(At, 1, 1); PG8_STAGE(PG8_SB(1, 0), b3, voffB); PG8_STAGE(PG8_SB(1, 1), b3 + hstep, voffB); PG8_STAGE(PG8_SA(1, 0), a3, voffA);
            PG8_WAIT_V(8); PG8_WAIT_L(0); PG8_BAR; PG8_MMA(1, 0, At, B0); PG8_MMA(1, 1, At, B1); PG8_BAR; PG8_SCHED;
            } else {
            PG8_LDB(B0, 0, 0); PG8_SCHED; PG8_LDA(At, 0, 0); PG8_STAGE(PG8_SA(1, 1), a1 + hstep, voffA);
            PG8_WAIT_L(8); PG8_BAR; PG8_WAIT_L(0); PG8_MMA(0, 0, At, B0); PG8_BAR; PG8_SCHED;
            PG8_LDB(B1, 0, 1); PG8_STAGE(PG8_SB(0, 0), b2, voffB);
            PG8_BAR; PG8_WAIT_L(0); PG8_MMA(0, 1, At, B1); PG8_BAR;
            PG8_LDA(At, 0, 1); PG8_STAGE(PG8_SA(0, 0), a2, voffA);
            PG8_BAR; PG8_WAIT_L(0); PG8_MMA(1, 0, At, B0); PG8_BAR; PG8_SCHED;
            PG8_STAGE(PG8_SB(0, 1), b2 + hstep, voffB);
            PG8_WAIT_V(6); PG8_BAR; PG8_MMA(1, 1, At, B1); PG8_BAR;
            PG8_LDB(B0, 1, 0); PG8_SCHED; PG8_LDA(At, 1, 0); PG8_STAGE(PG8_SA(0, 1), a2 + hstep, voffA);
            PG8_WAIT_L(8); PG8_BAR; PG8_WAIT_L(0); PG8_MMA(0, 0, At, B0); PG8_BAR; PG8_SCHED;
            PG8_LDB(B1, 1, 1); PG8_STAGE(PG8_SB(1, 0), b3, voffB);
            PG8_BAR; PG8_WAIT_L(0); PG8_MMA(0, 1, At, B1); PG8_BAR;
            PG8_LDA(At, 1, 1); PG8_STAGE(PG8_SA(1, 0), a3, voffA);
            PG8_BAR; PG8_WAIT_L(0); PG8_MMA(1, 0, At, B0); PG8_BAR; PG8_SCHED;
            PG8_STAGE(PG8_SB(1, 1), b3 + hstep, voffB);
            PG8_WAIT_V(6); PG8_BAR; PG8_MMA(1, 1, At, B1); PG8_BAR;
            }
        }
        if constexpr (ALIGN_EPI) { if (wr == 0) PG8_BAR; }
        if constexpr (!Epi::AFTER_DRAIN) { E(acc, cur, wr, wc, fr, fq); S.done(cur); }
        if (!has_next) break;
#pragma unroll
        for (int a = 0; a < 2; ++a)
#pragma unroll
            for (int b = 0; b < 2; ++b)
#pragma unroll
                for (int m = 0; m < 4; ++m)
#pragma unroll
                    for (int n = 0; n < 2; ++n) acc[a][b][m][n] = (f32x4){0.f, 0.f, 0.f, 0.f};
        cur = nxt; cA = nA; cB = nB; ++ui;
        if constexpr (ALIGN_EPI) { if (wr == 1) PG8_BAR; }
    }
    PG8_WAIT_V(0);
    if constexpr (!ALIGN_EPI) { if (wr == 0) PG8_BAR; }
    PG8_BAR;
    if constexpr (Epi::AFTER_DRAIN) { E.fused(acc, cur, wr, wc, fr, fq, lds, wid, lane); S.done(cur); }
#undef PG8_SA
#undef PG8_SB
#undef PG8_STAGE
#undef PG8_LDA
#undef PG8_LDB
#undef PG8_MMA
#undef PG8_WAIT_V
#undef PG8_WAIT_L
#undef PG8_BAR
#undef PG8_SCHED
}
}

constexpr int BATCH = 8, SEQ = 2048, DM = 1024, M = BATCH * SEQ, NQKV = 3072, DFF = 2816, HFF = DFF / 2;
constexpr float NORM_EPS = 1e-6f, SUBLN_EPS = 1e-5f, LOG2E = 1.4426950408889634f;
constexpr int NWAVES = 8, NTHREADS = NWAVES * 64;
constexpr int LDS_BYTES = 147456;

#define LAS __attribute__((address_space(3)))
typedef unsigned short bf16;
typedef unsigned v4u __attribute__((ext_vector_type(4)));
typedef unsigned v2u __attribute__((ext_vector_type(2)));
typedef float f32x4 __attribute__((ext_vector_type(4)));
typedef float f32x16 __attribute__((ext_vector_type(16)));
typedef short bf16x8 __attribute__((ext_vector_type(8)));
typedef short s16x4 __attribute__((ext_vector_type(4)));

constexpr size_t MiB = 1u << 20;
constexpr size_t WS_WQKV = 1 * MiB;
constexpr size_t WS_WO = 7 * MiB;
constexpr size_t WS_UP0 = 9 * MiB, WS_UP1 = 20 * MiB;
constexpr size_t WS_DN0 = 31 * MiB, WS_DN1 = 36 * MiB + 512 * 1024;
constexpr size_t WS_XN = 42 * MiB;
constexpr size_t WS_BIG = 74 * MiB;
constexpr size_t WS_A2 = 168 * MiB;
constexpr size_t WS_END = 256 * MiB;

__device__ __forceinline__ unsigned f2bf(float f) { unsigned u = __builtin_bit_cast(unsigned, f); return (u + 0x7fffu + ((u >> 16) & 1u)) >> 16; }
__device__ __forceinline__ unsigned pk2(float lo, float hi) { return pg8::cvt_pk_bf16(lo, hi); }
__device__ __forceinline__ float bflo(unsigned w) { return __builtin_bit_cast(float, w << 16); }
__device__ __forceinline__ float bfhi(unsigned w) { return __builtin_bit_cast(float, w & 0xffff0000u); }
__device__ __forceinline__ float wave_sum(float v) {
#pragma unroll
    for (int o = 1; o < 64; o <<= 1) v += __shfl_xor(v, o);
    return v;
}

template <int MODE>
__device__ __forceinline__ void transpose_item(const float* __restrict__ W, int K, int N, bf16* __restrict__ WT, LAS float* scr, int item, int lane) {
    const int nblk = N / 32, kb = item / nblk, nb = item % nblk, k0 = 64 * kb, n0 = 32 * nb;
    int d0 = n0;
    if (MODE == 1) { const int isv = n0 >= DFF; const int c = isv ? n0 - DFF : n0; const int half = c / HFF, idx = c % HFF; d0 = half * (2 * HFF) + (isv ? HFF : 0) + idx; }
#pragma unroll 8
    for (int i = 0; i < 32; ++i) { const int kk = 2 * i + (lane >> 5); scr[kk * 33 + (lane & 31)] = W[(size_t)(k0 + kk) * N + n0 + (lane & 31)]; }
    asm volatile("s_waitcnt lgkmcnt(0)" ::: "memory");
    const int c = lane & 7;
#pragma unroll
    for (int j = 0; j < 4; ++j) { const int n = (lane >> 3) + 8 * j; const LAS float* s = scr + (8 * c) * 33 + n;
        v4u o; o.x = pk2(s[0 * 33], s[1 * 33]); o.y = pk2(s[2 * 33], s[3 * 33]); o.z = pk2(s[4 * 33], s[5 * 33]); o.w = pk2(s[6 * 33], s[7 * 33]);
        *(v4u*)(WT + (size_t)(d0 + n) * K + k0 + 8 * c) = o; }
    asm volatile("s_waitcnt lgkmcnt(0)" ::: "memory");
}

__device__ __forceinline__ void rms_row_to_bf16(const float* __restrict__ xrow, const float* __restrict__ g, bf16* __restrict__ orow, int lane) {
    const f32x4* xr = (const f32x4*)xrow + lane; const f32x4* gr = (const f32x4*)g + lane;
    f32x4 v[4]; float s = 0.f;
#pragma unroll
    for (int j = 0; j < 4; ++j) { v[j] = xr[64 * j]; s += (v[j].x * v[j].x + v[j].y * v[j].y) + (v[j].z * v[j].z + v[j].w * v[j].w); }
    const float rs = 1.0f / sqrtf(wave_sum(s) * (1.f / DM) + NORM_EPS);
    v2u* o8 = (v2u*)orow + lane;
#pragma unroll
    for (int j = 0; j < 4; ++j) { const f32x4 gg = gr[64 * j]; v2u w; w.x = pk2(v[j].x * rs * gg.x, v[j].y * rs * gg.y); w.y = pk2(v[j].z * rs * gg.z, v[j].w * rs * gg.w); o8[64 * j] = w; }
}

__device__ __forceinline__ void rowwise_phase(int gw, int NGW, int lane, const float* __restrict__ MF, const float* Xin, float* Xout, const float* __restrict__ gA, const float* __restrict__ gB, bf16* __restrict__ XN) {
    for (int m = gw; m < M; m += NGW) {
        const f32x4* mr = (const f32x4*)(MF + (size_t)m * DM) + lane; const f32x4* xr = (const f32x4*)(Xin + (size_t)m * DM) + lane;
        f32x4 mv[4], xv[4]; float s = 0.f;
#pragma unroll
        for (int j = 0; j < 4; ++j) { mv[j] = mr[64 * j]; xv[j] = xr[64 * j]; s += (mv[j].x * mv[j].x + mv[j].y * mv[j].y) + (mv[j].z * mv[j].z + mv[j].w * mv[j].w); }
        const float rs = 1.0f / sqrtf(wave_sum(s) * (1.f / DM) + NORM_EPS);
        f32x4* xo = (f32x4*)(Xout + (size_t)m * DM) + lane; float s2 = 0.f;
#pragma unroll
        for (int j = 0; j < 4; ++j) { const f32x4 ga = ((const f32x4*)gA + lane)[64 * j]; xv[j] = xv[j] + mv[j] * rs * ga; xo[64 * j] = xv[j];
            s2 += (xv[j].x * xv[j].x + xv[j].y * xv[j].y) + (xv[j].z * xv[j].z + xv[j].w * xv[j].w); }
        if (XN) {
            const float rs2 = 1.0f / sqrtf(wave_sum(s2) * (1.f / DM) + NORM_EPS);
            v2u* o8 = (v2u*)(XN + (size_t)m * DM) + lane;
#pragma unroll
            for (int j = 0; j < 4; ++j) { const f32x4 gb = ((const f32x4*)gB + lane)[64 * j]; v2u w; w.x = pk2(xv[j].x * rs2 * gb.x, xv[j].y * rs2 * gb.y); w.y = pk2(xv[j].z * rs2 * gb.z, xv[j].w * rs2 * gb.w); o8[64 * j] = w; }
        }
    }
}

__device__ __forceinline__ void unpack8(const v4u w, float (&f)[8]) {
    f[0] = bflo(w.x); f[1] = bfhi(w.x); f[2] = bflo(w.y); f[3] = bfhi(w.y); f[4] = bflo(w.z); f[5] = bfhi(w.z); f[6] = bflo(w.w); f[7] = bfhi(w.w);
}
__device__ __forceinline__ v4u pack8(const float (&f)[8]) { v4u o; o.x = pk2(f[0], f[1]); o.y = pk2(f[2], f[3]); o.z = pk2(f[4], f[5]); o.w = pk2(f[6], f[7]); return o; }
__device__ __forceinline__ void load8f(const float* p, float (&f)[8]) { const f32x4 a = *(const f32x4*)p, b = *(const f32x4*)(p + 4); f[0] = a.x; f[1] = a.y; f[2] = a.z; f[3] = a.w; f[4] = b.x; f[5] = b.y; f[6] = b.z; f[7] = b.w; }

__device__ __forceinline__ void convmix_phase(int gtid, int nthr, const bf16* __restrict__ BCH, const float* __restrict__ cw, bf16* __restrict__ Y) {
    constexpr int RB = 16, NITEMS = 128 * (M / RB);
    for (int it = gtid; it < NITEMS; it += nthr) {
        const int grp = it & 127, rb = it >> 7, ch = grp * 8, row0 = rb * RB, s0 = row0 & (SEQ - 1);
        float w0[8], w1[8], w2[8]; load8f(cw + ch, w0); load8f(cw + DM + ch, w1); load8f(cw + 2 * DM + ch, w2);
        float p2[8], p1[8];
#pragma unroll
        for (int k = 0; k < 8; ++k) { p2[k] = 0.f; p1[k] = 0.f; }
        if (s0 > 0) {
            const bf16* r2 = BCH + (size_t)(row0 - 2) * NQKV + ch; float c[8], hv[8];
            unpack8(*(const v4u*)(r2 + 1024), c); unpack8(*(const v4u*)(r2 + 2048), hv);
#pragma unroll
            for (int k = 0; k < 8; ++k) p2[k] = c[k] * hv[k];
            unpack8(*(const v4u*)(r2 + NQKV + 1024), c); unpack8(*(const v4u*)(r2 + NQKV + 2048), hv);
#pragma unroll
            for (int k = 0; k < 8; ++k) p1[k] = c[k] * hv[k];
        }
#pragma unroll 4
        for (int r = 0; r < RB; ++r) {
            const bf16* rp = BCH + (size_t)(row0 + r) * NQKV + ch; float b[8], c[8], hv[8], y[8];
            unpack8(*(const v4u*)rp, b); unpack8(*(const v4u*)(rp + 1024), c); unpack8(*(const v4u*)(rp + 2048), hv);
#pragma unroll
            for (int k = 0; k < 8; ++k) { const float p0 = c[k] * hv[k]; y[k] = b[k] * (w0[k] * p2[k] + w1[k] * p1[k] + w2[k] * p0); p2[k] = p1[k]; p1[k] = p0; }
            *(v4u*)(Y + (size_t)(row0 + r) * DM + ch) = pack8(y);
        }
    }
}

__device__ __forceinline__ void convffn_phase(int gtid, int nthr, const bf16* __restrict__ U, const float* __restrict__ cw, bf16* __restrict__ A2, int hf) {
    constexpr int RB = 16, NG = HFF / 8, NITEMS = NG * (M / RB);
    for (int it = gtid; it < NITEMS; it += nthr) {
        const int grp = it % NG, rb = it / NG, idx = grp * 8, chg = hf * HFF + idx, row0 = rb * RB, s0 = row0 & (SEQ - 1);
        float wg0[8], wg1[8], wg2[8], wv0[8], wv1[8], wv2[8];
        load8f(cw + chg, wg0); load8f(cw + 2 * DFF + chg, wg1); load8f(cw + 4 * DFF + chg, wg2);
        load8f(cw + DFF + chg, wv0); load8f(cw + 3 * DFF + chg, wv1); load8f(cw + 5 * DFF + chg, wv2);
        float g2[8], g1[8], v2[8], v1[8];
#pragma unroll
        for (int k = 0; k < 8; ++k) { g2[k] = 0.f; g1[k] = 0.f; v2[k] = 0.f; v1[k] = 0.f; }
        if (s0 > 0) {
            const bf16* r2 = U + (size_t)(row0 - 2) * DFF + idx;
            unpack8(*(const v4u*)r2, g2); unpack8(*(const v4u*)(r2 + HFF), v2);
            unpack8(*(const v4u*)(r2 + DFF), g1); unpack8(*(const v4u*)(r2 + DFF + HFF), v1);
        }
#pragma unroll 4
        for (int r = 0; r < RB; ++r) {
            const bf16* rp = U + (size_t)(row0 + r) * DFF + idx; float g0[8], v0[8], y[8];
            unpack8(*(const v4u*)rp, g0); unpack8(*(const v4u*)(rp + HFF), v0);
#pragma unroll
            for (int k = 0; k < 8; ++k) {
                const float G = wg0[k] * g2[k] + wg1[k] * g1[k] + wg2[k] * g0[k];
                const float V = wv0[k] * v2[k] + wv1[k] * v1[k] + wv2[k] * v0[k];
                const float e = __builtin_amdgcn_exp2f(-G * LOG2E);
                y[k] = G * __builtin_amdgcn_rcpf(1.0f + e) * V;
                g2[k] = g1[k]; g1[k] = g0[k]; v2[k] = v1[k]; v1[k] = v0[k];
            }
            *(v4u*)(A2 + (size_t)(row0 + r) * DFF + chg) = pack8(y);
        }
    }
}

namespace att {
typedef LAS const char* lcp;
typedef float f32x2_t __attribute__((ext_vector_type(2))); typedef __bf16 bf16x2_t __attribute__((ext_vector_type(2)));
__device__ __forceinline__ unsigned cvtpk(float lo, float hi) { f32x2_t v = {lo, hi}; bf16x2_t b = __builtin_convertvector(v, bf16x2_t); return __builtin_bit_cast(unsigned, b); }
__device__ __forceinline__ s16x4 vtr(lcp p) { return __builtin_bit_cast(s16x4, __builtin_amdgcn_ds_read_tr16_b64_v4i16((LAS s16x4*)p)); }
__device__ __forceinline__ float xhalf_max(float v) { auto rr = __builtin_amdgcn_permlane32_swap(__float_as_uint(v), __float_as_uint(v), false, false); return fmaxf(__uint_as_float(rr[0]), __uint_as_float(rr[1])); }
__device__ __forceinline__ float xhalf_sum(float v) { auto rr = __builtin_amdgcn_permlane32_swap(__float_as_uint(v), __float_as_uint(v), false, false); return __uint_as_float(rr[0]) + __uint_as_float(rr[1]); }
__device__ __forceinline__ void glds16(const void* gsrc, unsigned lds_dst) { unsigned keep;
    asm volatile("s_mov_b32 %0, m0\n\ts_mov_b32 m0, %2\n\ts_nop 0\n\tglobal_load_lds_dwordx4 %1, off\n\ts_mov_b32 m0, %0" : "=&s"(keep) : "v"(gsrc), "s"(lds_dst) : "memory"); }
constexpr int TILE_BYTES = 32768, K1_OFF = 0, K2_OFF = 8192, V_OFF = 16384, Q_OFF = 2 * TILE_BYTES;

__device__ __forceinline__ void attn_map(f32x16 (&o)[4], float& m, float& l, lcp qb, lcp kb, lcp vp, float dbase, float nslope) {
    f32x16 p0, p1;
#pragma unroll
    for (int r = 0; r < 16; ++r) { p0[r] = 0.f; p1[r] = 0.f; }
    __builtin_amdgcn_sched_barrier(0);
#pragma unroll
    for (int d0 = 0; d0 < 4; ++d0) {
        const bf16x8 qf = *(const LAS bf16x8*)(qb + d0 * 1024);
        const bf16x8 a0 = *(const LAS bf16x8*)(kb + d0 * 2048), a1 = *(const LAS bf16x8*)(kb + d0 * 2048 + 512);
        p0 = __builtin_amdgcn_mfma_f32_32x32x16_bf16(a0, qf, p0, 0, 0, 0);
        p1 = __builtin_amdgcn_mfma_f32_32x32x16_bf16(a1, qf, p1, 0, 0, 0);
    }
    __builtin_amdgcn_sched_barrier(0);
    float rm = -INFINITY;
#pragma unroll
    for (int g = 0; g < 4; ++g) {
#pragma unroll
        for (int i = 0; i < 4; ++i) { const int r = 4 * g + i; const float c = (float)((r & 3) + 8 * (r >> 2));
            p0[r] = fmaf(nslope, fabsf(dbase - c), p0[r]); p1[r] = fmaf(nslope, fabsf(dbase - 32.f - c), p1[r]);
            rm = fmaxf(rm, fmaxf(p0[r], p1[r])); }
        __builtin_amdgcn_sched_barrier(0);
    }
    rm = xhalf_max(rm);
    const float mn = fmaxf(m, rm), alpha = __builtin_amdgcn_exp2f(m - mn); m = mn;
    float s = 0.f;
    v4u pw[4];
    __builtin_amdgcn_sched_barrier(0);
#pragma unroll
    for (int g = 0; g < 4; ++g) {
        float e[8];
#pragma unroll
        for (int i = 0; i < 8; ++i) { e[i] = __builtin_amdgcn_exp2f(((g < 2) ? p0[(g & 1) * 8 + i] : p1[(g & 1) * 8 + i]) - mn); }
        s += ((e[0] + e[1]) + (e[2] + e[3])) + ((e[4] + e[5]) + (e[6] + e[7]));
        pw[g] = (v4u){cvtpk(e[0], e[1]), cvtpk(e[2], e[3]), cvtpk(e[4], e[5]), cvtpk(e[6], e[7])};
        __builtin_amdgcn_sched_barrier(0);
    }
    l = l * alpha + s;
#pragma unroll
    for (int d0 = 0; d0 < 4; ++d0) o[d0] = o[d0] * alpha;
    __builtin_amdgcn_sched_barrier(0);
#pragma unroll
    for (int d0 = 0; d0 < 4; ++d0) {
#pragma unroll
        for (int ks = 0; ks < 4; ++ks) {
            const s16x4 lo = vtr(vp + (d0 * 4 + ks) * 1024), hh = vtr(vp + (d0 * 4 + ks) * 1024 + 512);
            const bf16x8 vf = (bf16x8){lo[0], lo[1], lo[2], lo[3], hh[0], hh[1], hh[2], hh[3]};
            o[d0] = __builtin_amdgcn_mfma_f32_32x32x16_bf16(vf, __builtin_bit_cast(bf16x8, pw[ks]), o[d0], 0, 0, 0);
        }
        __builtin_amdgcn_sched_barrier(0);
    }
}

__device__ __forceinline__ void attn_unit(const bf16* QKV, bf16* O, int b, int h, int u, LAS char* lds, float lam, float oscale, const float* sg) {
    int tid = threadIdx.x; asm volatile("" : "+v"(tid));
    asm volatile("" : "+s"(QKV), "+s"(O), "+s"(sg));
    const int lane = tid & 63, r32 = lane & 31, hi = lane >> 5; const int wid = __builtin_amdgcn_readfirstlane(tid >> 6);
    const size_t rowbase = (size_t)b * SEQ; const int qpos = u * 256 + wid * 32 + r32;
    const bf16* qp = QKV + (rowbase + qpos) * NQKV + h * 64 + hi * 8;
    LAS char* qlds = lds + Q_OFF + wid * 8192 + hi * 512 + r32 * 16;
#pragma unroll
    for (int d0 = 0; d0 < 4; ++d0) { *(LAS bf16x8*)(qlds + d0 * 1024) = *(const bf16x8*)(qp + d0 * 16); *(LAS bf16x8*)(qlds + 4096 + d0 * 1024) = *(const bf16x8*)(qp + 512 + d0 * 16); }
    const int NT = 4 * u + 4, my_nt = 4 * u + (wid >> 1) + 1;
    const bf16* ksrc = QKV + (rowbase + lane) * NQKV + 1024 + h * 64 + wid * 8;
    const bf16* vsrc = QKV + (rowbase + 16 * ((2 * wid) & 3) + (lane >> 2)) * NQKV + 2048 + h * 128 + ((2 * wid) >> 2) * 32 + (lane & 3) * 8;
    const unsigned lds0 = (unsigned)(uintptr_t)lds;
    const float nslope = -exp2f(-(float)(h + 1)) * LOG2E;
#define ATT_DMA(t, buf) do { const size_t go = (size_t)(t) * 64 * NQKV; const unsigned bb_ = (unsigned)__builtin_amdgcn_readfirstlane(lds0 + (buf) * TILE_BYTES + wid * 1024); \
        glds16(ksrc + go, bb_ + K1_OFF); glds16(ksrc + go + 512, bb_ + K2_OFF); glds16(vsrc + go, bb_ + V_OFF + wid * 1024); glds16(vsrc + go + (size_t)16 * NQKV, bb_ + V_OFF + wid * 1024 + 1024); } while (0)
    f32x16 o1[4], o2[4];
#pragma unroll
    for (int d0 = 0; d0 < 4; ++d0)
#pragma unroll
        for (int r = 0; r < 16; ++r) { o1[d0][r] = 0.f; o2[d0][r] = 0.f; }
    float m1 = -INFINITY, m2 = -INFINITY, l1 = 0.f, l2 = 0.f;
    ATT_DMA(0, 0);
    asm volatile("s_waitcnt vmcnt(0) lgkmcnt(0)" ::: "memory");
    __syncthreads();
    const int koff = hi * 1024 + r32 * 16;
    const int voff = V_OFF + ((lane >> 4) & 1) * 32 + (lane & 3) * 8 + (4 * hi + ((lane & 15) >> 2)) * 64;
    for (int t = 0; t < NT; ++t) {
        if (t + 1 < NT) ATT_DMA(t + 1, (t + 1) & 1);
        if (t < my_nt) {
            lcp bb = (lcp)(lds + (t & 1) * TILE_BYTES);
            const float dbase = (float)(qpos - 64 * t - 4 * hi);
            attn_map(o1, m1, l1, (lcp)qlds, bb + K1_OFF + koff, bb + voff, dbase, nslope);
            attn_map(o2, m2, l2, (lcp)qlds + 4096, bb + K2_OFF + koff, bb + voff, dbase, nslope);
        }
        asm volatile("s_waitcnt vmcnt(0) lgkmcnt(0)" ::: "memory");
        __syncthreads();
    }
#undef ATT_DMA
    l1 = xhalf_sum(l1); l2 = xhalf_sum(l2);
    int tid2 = threadIdx.x; asm volatile("" : "+v"(tid2));
    const int hi2 = (tid2 >> 5) & 1, qpos2 = u * 256 + wid * 32 + (tid2 & 31);
    const float i1 = 1.0f / l1, i2 = lam / l2; float ss = 0.f;
#pragma unroll
    for (int d0 = 0; d0 < 4; ++d0)
#pragma unroll
        for (int r = 0; r < 16; ++r) { const float v = o1[d0][r] * i1 - o2[d0][r] * i2; o1[d0][r] = v; ss += v * v; }
    ss = xhalf_sum(ss);
    const float rs = oscale / sqrtf(ss * (1.f / 128.f) + SUBLN_EPS);
    bf16* op = O + (rowbase + qpos2) * DM + h * 128 + 4 * hi2;
#pragma unroll
    for (int d0 = 0; d0 < 4; ++d0)
#pragma unroll
        for (int g4 = 0; g4 < 4; ++g4) { const int v0 = 32 * d0 + 8 * g4; const f32x4 gg = *(const f32x4*)(sg + v0 + 4 * hi2);
            v2u w; w.x = pk2(o1[d0][4 * g4] * rs * gg.x, o1[d0][4 * g4 + 1] * rs * gg.y); w.y = pk2(o1[d0][4 * g4 + 2] * rs * gg.z, o1[d0][4 * g4 + 3] * rs * gg.w);
            *(v2u*)(op + v0) = w; }
}
}

struct Args { const float* in[15]; float* out; unsigned char* ws; int ph_lo, ph_hi; };
enum { IN_X = 0, IN_NG, IN_WQKV, IN_WO, IN_LQ1, IN_LK1, IN_LQ2, IN_LK2, IN_SG, IN_WIN, IN_CW, IN_WOUT, IN_WUP, IN_FCW, IN_WDN };
constexpr int NPHASES = 21;

template <int ph>
__device__ __forceinline__ void run_phase(const Args& a, LAS unsigned char* lds) {
    const int tid = threadIdx.x, lane = tid & 63, wave = __builtin_amdgcn_readfirstlane(tid >> 6);
    const int G = gridDim.x, bx = blockIdx.x;
    const int vcu = (G % 8 == 0) ? (bx % 8) * (G / 8) + bx / 8 : bx;
    const int gw = vcu * NWAVES + wave, NGW = G * NWAVES, gtid = vcu * NTHREADS + tid, nthr = G * NTHREADS;
    unsigned char* ws = a.ws;
    bf16* const XN = (bf16*)(ws + WS_XN); bf16* const BIG = (bf16*)(ws + WS_BIG); float* const MF = (float*)(ws + WS_BIG); bf16* const A2 = (bf16*)(ws + WS_A2);
    bf16* const WQKV = (bf16*)(ws + WS_WQKV); bf16* const WO = (bf16*)(ws + WS_WO);
    const float* ng = a.in[IN_NG];
    LAS float* scr = (LAS float*)(lds + wave * 16384);
    (void)gw; (void)NGW; (void)gtid; (void)nthr; (void)XN; (void)BIG; (void)MF; (void)A2; (void)WQKV; (void)WO; (void)ng; (void)scr; (void)lane;
    {
        constexpr int L = (ph >= 11) ? 1 : 0, lp = ph - 10 * L;
        if constexpr (ph == 0) {
            constexpr int I_QKV = 16 * 96, I_O = 16 * 32, I_UP = 16 * 176, I_DN = 44 * 32, NIT = I_QKV + I_O + 2 * I_UP + 2 * I_DN;
            for (int it = gw; it < NIT; it += NGW) {
                int r = it;
                if (r < I_QKV) { transpose_item<0>(a.in[IN_WQKV], 1024, 3072, WQKV, scr, r, lane); continue; } r -= I_QKV;
                if (r < I_O) { transpose_item<0>(a.in[IN_WO], 1024, 1024, WO, scr, r, lane); continue; } r -= I_O;
                if (r < I_UP) { transpose_item<1>(a.in[IN_WUP], 1024, 2 * DFF, (bf16*)(ws + WS_UP0), scr, r, lane); continue; } r -= I_UP;
                if (r < I_UP) { transpose_item<1>(a.in[IN_WUP] + (size_t)1024 * 2 * DFF, 1024, 2 * DFF, (bf16*)(ws + WS_UP1), scr, r, lane); continue; } r -= I_UP;
                if (r < I_DN) { transpose_item<0>(a.in[IN_WDN], DFF, 1024, (bf16*)(ws + WS_DN0), scr, r, lane); continue; } r -= I_DN;
                transpose_item<0>(a.in[IN_WDN] + (size_t)DFF * 1024, DFF, 1024, (bf16*)(ws + WS_DN1), scr, r, lane);
            }
            for (int m = gw; m < M; m += NGW) rms_row_to_bf16(a.in[IN_X] + (size_t)m * DM, ng, XN + (size_t)m * DM, lane);
        } else if constexpr (lp == 1) {
            pg8::Gemm g{XN, WQKV, M, NQKV, DM}; pg8::StaticOrder S; S.init(M, NQKV, G, bx);
            pg8::EpiBf16 E{BIG, NQKV, (L == 0) ? 1024 : 0, 0.125f * LOG2E};
#if !defined(NO_GEMM) && !defined(NO_GEMM_BF)
            pg8::gemm_phase<pg8::EpiBf16, pg8::StaticOrder, true, true>(lds, g, S, E);
#endif
        } else if constexpr (lp == 5 || lp == 7) {
            const bf16* Bt = (bf16*)(ws + (L ? WS_UP1 : WS_UP0)) + (size_t)(lp == 7) * DFF * DM;
            pg8::Gemm g{XN, Bt, M, DFF, DM}; pg8::StaticOrder S; S.init(M, DFF, G, bx);
            pg8::EpiBf16 E{BIG, DFF, 0, 1.f};
#if !defined(NO_GEMM) && !defined(NO_GEMM_BF)
            pg8::gemm_phase<pg8::EpiBf16, pg8::StaticOrder, true, true>(lds, g, S, E);
#endif
        } else if constexpr (lp == 2) {
            if constexpr (L == 0) {
                float s1 = 0.f, s2 = 0.f;
                for (int i = 0; i < 64; ++i) { s1 += a.in[IN_LQ1][i] * a.in[IN_LK1][i]; s2 += a.in[IN_LQ2][i] * a.in[IN_LK2][i]; }
                const float lam_init = 0.2f, lam = expf(s1) - expf(s2) + lam_init;
#ifndef NO_ATTN
                for (int pi = vcu; pi < 256; pi += G) {
                    const int bh = pi >> 2, s = pi & 3;
#pragma nounroll
                    for (int k = 0; k < 2; ++k)
                        att::attn_unit(BIG, XN, bh >> 3, bh & 7, k ? 7 - s : s, (LAS char*)lds, lam, 1.0f - lam_init, a.in[IN_SG]);
                }
#endif
            } else {
                convmix_phase(gtid, nthr, BIG, a.in[IN_CW], XN);
            }
        } else if constexpr (lp == 3) {
            pg8::Gemm g{XN, WO, M, DM, DM}; pg8::StaticOrder S; S.init(M, DM, G, bx);
            pg8::EpiF32 E{MF, DM};
#if !defined(NO_GEMM) && !defined(NO_GEMM_F32)
            pg8::gemm_phase<pg8::EpiF32, pg8::StaticOrder, true, true>(lds, g, S, E);
#endif
        } else if constexpr (lp == 9) {
            pg8::Gemm g{A2, (bf16*)(ws + (L ? WS_DN1 : WS_DN0)), M, DM, DFF}; pg8::StaticOrder S; S.init(M, DM, G, bx);
            pg8::EpiF32 E{MF, DM};
#if !defined(NO_GEMM) && !defined(NO_GEMM_F32)
            pg8::gemm_phase<pg8::EpiF32, pg8::StaticOrder, true, true>(lds, g, S, E);
#endif
        } else if constexpr (lp == 4 || lp == 10) {
            const float* gA = ng + (size_t)(L * 4 + (lp == 4 ? 1 : 3)) * DM;
            const float* gB = (lp == 4) ? ng + (size_t)(L * 4 + 2) * DM : ng + (size_t)4 * DM;
            const float* Xin = (L == 0 && lp == 4) ? a.in[IN_X] : a.out;
            bf16* xn = (L == 1 && lp == 10) ? (bf16*)nullptr : XN;
            if (L == 0 && lp == 4) {
                constexpr int I_IN = 16 * 96, I_OUT = 16 * 32;
                for (int it = gw; it < I_IN + I_OUT; it += NGW) {
                    if (it < I_IN) transpose_item<0>(a.in[IN_WIN], 1024, 3072, WQKV, scr, it, lane);
                    else transpose_item<0>(a.in[IN_WOUT], 1024, 1024, WO, scr, it - I_IN, lane);
                }
            }
            rowwise_phase(gw, NGW, lane, MF, Xin, a.out, gA, gB, xn);
        } else {
            convffn_phase(gtid, nthr, BIG, a.in[IN_FCW] + (size_t)L * 3 * 2 * DFF, A2, lp == 8);
        }
    }
}

__global__ void __launch_bounds__(NTHREADS, 2) fwd(Args a) {
    extern __shared__ __attribute__((aligned(16))) unsigned char lds_raw[];
    LAS unsigned char* lds = (LAS unsigned char*)lds_raw;
    cg::grid_group grid = cg::this_grid();
#define RUN(k) if (a.ph_lo <= (k) && (k) < a.ph_hi) { run_phase<k>(a, lds); if ((k) + 1 < a.ph_hi) grid.sync(); }
    RUN(0) RUN(1) RUN(2) RUN(3) RUN(4) RUN(5) RUN(6) RUN(7) RUN(8) RUN(9) RUN(10)
    RUN(11) RUN(12) RUN(13) RUN(14) RUN(15) RUN(16) RUN(17) RUN(18) RUN(19) RUN(20)
#undef RUN
}

extern "C" void kernel_launch(void* const* d_in, const int* in_sizes, int n_in, void* d_out, int out_size, void* d_ws, size_t ws_size, hipStream_t stream) {
    static int grid = 0;
    if (grid == 0) {
        if (n_in != 15 || in_sizes[0] != M * DM || out_size != M * DM || ws_size < WS_END) { fprintf(stderr, "kernel_launch: unexpected shapes (n_in %d, in0 %d, out %d, ws %zu)\n", n_in, n_in > 0 ? in_sizes[0] : -1, out_size, ws_size); grid = -1; return; }
        int dev = 0, cus = 0, per_cu = 0;
        hipGetDevice(&dev); hipDeviceGetAttribute(&cus, hipDeviceAttributeMultiprocessorCount, dev);
        if (hipFuncSetAttribute((const void*)fwd, hipFuncAttributeMaxDynamicSharedMemorySize, LDS_BYTES) != hipSuccess) { fprintf(stderr, "kernel_launch: hipFuncSetAttribute failed\n"); grid = -1; return; }
        if (hipOccupancyMaxActiveBlocksPerMultiprocessor(&per_cu, (const void*)fwd, NTHREADS, LDS_BYTES) != hipSuccess || per_cu < 1) { fprintf(stderr, "kernel_launch: occupancy query gave %d\n", per_cu); per_cu = 1; }
        (void)hipGetLastError();
        grid = cus * per_cu;
        fprintf(stderr, "kernel_launch: grid %d (cus %d x %d)\n", grid, cus, per_cu);
    }
    if (grid < 0) return;
    Args a{};
    for (int i = 0; i < 15; ++i) a.in[i] = (const float*)d_in[i];
    a.out = (float*)d_out; a.ws = (unsigned char*)d_ws;
#if defined(MULTI_LAUNCH)
    for (int ph = 0; ph < NPHASES; ++ph) { a.ph_lo = ph; a.ph_hi = ph + 1; hipLaunchKernelGGL(fwd, dim3(grid), dim3(NTHREADS), LDS_BYTES, stream, a); }
#else
    a.ph_lo = 0; a.ph_hi = NPHASES;
    void* args[] = {&a};
    hipError_t e = hipLaunchCooperativeKernel((const void*)fwd, dim3(grid), dim3(NTHREADS), args, LDS_BYTES, stream);
    if (e != hipSuccess) fprintf(stderr, "kernel_launch: cooperative launch failed: %s (grid %d)\n", hipGetErrorString(e), grid);
#endif
}
```

```cpp
#include <hip/hip_runtime.h>
#include <hip/hip_cooperative_groups.h>
#include <cstdio>
#include <cstdint>
#include <cmath>
namespace cg = cooperative_groups;
namespace pg8 {
#define PG8_LAS __attribute__((address_space(3)))
typedef unsigned short bf16_t;
typedef short bf16x8 __attribute__((ext_vector_type(8)));
typedef float f32x4 __attribute__((ext_vector_type(4)));
typedef unsigned u32x4 __attribute__((ext_vector_type(4)));
constexpr int BM = 256, BK = 64, HALF = 128, HTB = HALF * BK * 2  , STAGE_BYTES = 8 * HTB, NXCD = 8, WGM = 8;

__host__ __device__ __forceinline__ int lds_byte(int r, int c) { const int st = (r >> 4) * 2 + (c >> 5), rr = r & 15, cc = c & 31, ob = rr * 64 + cc * 2; return st * 1024 + (ob ^ (((ob >> 9) & 1) << 5)); }
__host__ __device__ __forceinline__ void stage_rc(int b, int& R, int& C) { const int st = b / 1024, sb = b % 1024, swz = sb ^ (((sb >> 9) & 1) << 5); R = (st >> 1) * 16 + swz / 64; C = (st & 1) * 32 + (swz % 64) / 2; }
__host__ __device__ __forceinline__ int perm32(int rho) { const int n = rho >> 4, i = rho & 15; return 8 * (i >> 2) + 4 * n + (i & 3); }

struct Unit { int pm, pn; };
struct Gemm { const bf16_t* A; const bf16_t* Bt; int M, N, K; };

struct StaticOrder {
    int nM, nN, nwg, G, c;
    __host__ __device__ void init(int M, int N, int G_, int c_) { nM = M / BM; nN = N / BM; nwg = nM * nN; G = G_; c = c_; }
    __host__ __device__ bool next(int i, Unit& u) const {
        const long L = (long)i * G + c; if (L >= nwg) return false;
        int wgid = (int)L; { const int q = nwg / NXCD, r = nwg % NXCD, xcd = wgid % NXCD, off = wgid / NXCD; wgid = (xcd < r ? xcd * (q + 1) : r * (q + 1) + (xcd - r) * q) + off; }
        const int nig = WGM * nN, gid = wgid / nig, fm = gid * WGM, gsz = (nM - fm) < WGM ? (nM - fm) : WGM;
        u.pm = fm + ((wgid % nig) % gsz); u.pn = (wgid % nig) / gsz; return true;
    }
    __device__ __forceinline__ void a_ready(const Unit&) const {}
    __device__ __forceinline__ void done(const Unit&) const {}
};

__device__ __forceinline__ unsigned cvt_pk_bf16(float lo, float hi) { unsigned r; asm volatile("v_cvt_pk_bf16_f32 %0, %1, %2" : "=v"(r) : "v"(lo), "v"(hi)); return r; }
struct EpiBf16 {
    static constexpr bool PERM = true, AFTER_DRAIN = false;
    bf16_t* O; int ldc; int scale_cols; float scale0;
    __device__ __forceinline__ void operator()(const f32x4 (&acc)[2][2][4][2], const Unit& u, int wr, int wc, int fr, int fq) const {
        const int row0 = u.pm * BM + wr * 64 + fr; const int colt = u.pn * BM;
        const float sc = (colt < scale_cols) ? scale0 : 1.f;
        const int col0 = colt + wc * 32 + 8 * fq;
#pragma unroll
        for (int ai = 0; ai < 2; ++ai)
#pragma unroll
            for (int m = 0; m < 4; ++m) { bf16_t* rowp = O + (size_t)(row0 + ai * HALF + m * 16) * ldc + col0;
#pragma unroll
                for (int bj = 0; bj < 2; ++bj) { f32x4 v0 = acc[ai][bj][m][0] * sc, v1 = acc[ai][bj][m][1] * sc;
                    u32x4 w; w.x = cvt_pk_bf16(v0[0], v0[1]); w.y = cvt_pk_bf16(v0[2], v0[3]); w.z = cvt_pk_bf16(v1[0], v1[1]); w.w = cvt_pk_bf16(v1[2], v1[3]);
                    *(u32x4*)(rowp + bj * HALF) = w; } }
    }
};
struct EpiF32 {
    static constexpr bool PERM = true, AFTER_DRAIN = false;
    float* O; int ldc;
    __device__ __forceinline__ void operator()(const f32x4 (&acc)[2][2][4][2], const Unit& u, int wr, int wc, int fr, int fq) const {
        const int row0 = u.pm * BM + wr * 64 + fr; const int col0 = u.pn * BM + wc * 32 + 8 * fq;
#pragma unroll
        for (int ai = 0; ai < 2; ++ai)
#pragma unroll
            for (int m = 0; m < 4; ++m) { float* rowp = O + (size_t)(row0 + ai * HALF + m * 16) * ldc + col0;
#pragma unroll
                for (int bj = 0; bj < 2; ++bj) { *(f32x4*)(rowp + bj * HALF) = acc[ai][bj][m][0]; *(f32x4*)(rowp + bj * HALF + 4) = acc[ai][bj][m][1]; } }
    }
};

template <class Epi, class Sched, bool ALIGN_EPI = false, bool SP2 = false>
__device__ __forceinline__ void gemm_phase(PG8_LAS unsigned char* lds, const Gemm g, const Sched& S, const Epi& E) {
    const int tid = threadIdx.x, wid = __builtin_amdgcn_readfirstlane(tid >> 6), lane = tid & 63, wr = wid >> 2, wc = wid & 3, fr = lane & 15, fq = lane >> 4;
    const int K = g.K, nt = K / BK;
    unsigned voffA[2], voffB[2];
#pragma unroll
    for (int i = 0; i < 2; ++i) { int R, C; stage_rc(tid * 16 + i * 8192, R, C); const int Rb = Epi::PERM ? ((R & ~31) + perm32(R & 31)) : R;
        voffA[i] = (unsigned)(R * K + C) * 2u; voffB[i] = (unsigned)(Rb * K + C) * 2u; }
    const size_t kstep = (size_t)(BK * 2);
    const size_t hstep = (size_t)HALF * K * 2;
    const size_t tstep = 2 * hstep;
    const unsigned ldsw = (unsigned)wid * 1024u;
    const int aoff = lds_byte(wr * 64 + fr, fq * 8), boff = lds_byte(wc * 32 + fr, fq * 8);
#define PG8_SA(b, h) (((b) * 2 + (h)) * HTB)
#define PG8_SB(b, h) ((4 + (b) * 2 + (h)) * HTB)
#define PG8_STAGE(bufoff, gbase, voff) do { _Pragma("unroll") for (int _i = 0; _i < 2; ++_i) \
        __builtin_amdgcn_global_load_lds((const unsigned*)((const char*)(gbase) + (voff)[_i]), (PG8_LAS unsigned*)(lds + (bufoff) + ldsw + _i * 8192), 16, 0, 0); } while (0)
#define PG8_LDA(dst, b, h) do { _Pragma("unroll") for (int m = 0; m < 4; ++m) _Pragma("unroll") for (int k = 0; k < 2; ++k) dst[m][k] = *(const PG8_LAS bf16x8*)(lds + PG8_SA(b, h) + aoff + m * 2048 + k * 1024); } while (0)
#define PG8_LDB(dst, b, h) do { _Pragma("unroll") for (int n = 0; n < 2; ++n) _Pragma("unroll") for (int k = 0; k < 2; ++k) dst[n][k] = *(const PG8_LAS bf16x8*)(lds + PG8_SB(b, h) + boff + n * 2048 + k * 1024); } while (0)
#define PG8_MMA(ai, bj, At, Bt) do { __builtin_amdgcn_s_setprio(1); _Pragma("unroll") for (int m = 0; m < 4; ++m) _Pragma("unroll") for (int n = 0; n < 2; ++n) _Pragma("unroll") for (int k = 0; k < 2; ++k) \
        acc[ai][bj][m][n] = __builtin_amdgcn_mfma_f32_16x16x32_bf16(Bt[n][k], At[m][k], acc[ai][bj][m][n], 0, 0, 0); __builtin_amdgcn_s_setprio(0); } while (0)
#define PG8_WAIT_V(n) asm volatile("s_waitcnt vmcnt(" #n ")" ::: "memory")
#define PG8_WAIT_L(n) asm volatile("s_waitcnt lgkmcnt(" #n ")" ::: "memory")
#define PG8_BAR __builtin_amdgcn_s_barrier()
#define PG8_SCHED __builtin_amdgcn_sched_barrier(0)
    Unit cur, nxt; int ui = 0;
    if (!S.next(0, cur)) return;
    f32x4 acc[2][2][4][2];
#pragma unroll
    for (int a = 0; a < 2; ++a)
#pragma unroll
        for (int b = 0; b < 2; ++b)
#pragma unroll
            for (int m = 0; m < 4; ++m)
#pragma unroll
                for (int n = 0; n < 2; ++n) acc[a][b][m][n] = (f32x4){0.f, 0.f, 0.f, 0.f};
    bf16x8 At[4][2], B0[2][2], B1[2][2];
    const char* cA = (const char*)g.A + (size_t)cur.pm * tstep; const char* cB = (const char*)g.Bt + (size_t)cur.pn * tstep;
    S.a_ready(cur);
    if constexpr (SP2) {
        PG8_STAGE(PG8_SB(0, 0), cB, voffB); PG8_STAGE(PG8_SB(0, 1), cB + hstep, voffB); PG8_STAGE(PG8_SA(0, 0), cA, voffA); PG8_STAGE(PG8_SA(0, 1), cA + hstep, voffA);
        if (wr == 1) PG8_BAR;
        PG8_WAIT_V(2); PG8_BAR;
        PG8_STAGE(PG8_SB(1, 0), cB + kstep, voffB); PG8_STAGE(PG8_SA(1, 0), cA + kstep, voffA); PG8_STAGE(PG8_SB(1, 1), cB + hstep + kstep, voffB);
        PG8_WAIT_V(6); PG8_BAR;
    } else {
        PG8_STAGE(PG8_SB(0, 0), cB, voffB); PG8_STAGE(PG8_SA(0, 0), cA, voffA); PG8_STAGE(PG8_SB(0, 1), cB + hstep, voffB); PG8_STAGE(PG8_SA(0, 1), cA + hstep, voffA);
        if (wr == 1) PG8_BAR;
        PG8_WAIT_V(4); PG8_BAR;
        PG8_STAGE(PG8_SB(1, 0), cB + kstep, voffB); PG8_STAGE(PG8_SA(1, 0), cA + kstep, voffA); PG8_STAGE(PG8_SB(1, 1), cB + hstep + kstep, voffB);
        PG8_WAIT_V(6); PG8_BAR;
    }
    for (;;) {
        const bool has_next = S.next(ui + 1, nxt);
        const char* nA = has_next ? (const char*)g.A + (size_t)nxt.pm * tstep : cA; const char* nB = has_next ? (const char*)g.Bt + (size_t)nxt.pn * tstep : cB;
        for (int t = 0; t < nt; t += 2) {
            const bool last = (t == nt - 2);
            const char* a1 = cA + (size_t)(t + 1) * kstep;
            const char* a2 = last ? nA : cA + (size_t)(t + 2) * kstep; const char* b2 = last ? nB : cB + (size_t)(t + 2) * kstep;
            const char* a3 = a2 + kstep; const char* b3 = b2 + kstep;
            if (last && has_next) S.a_ready(nxt);
            if constexpr (SP2) {
            PG8_LDB(B0, 0, 0); PG8_LDB(B1, 0, 1); PG8_SCHED; PG8_LDA(At, 0, 0); PG8_STAGE(PG8_SA(1, 1), a1 + hstep, voffA);
            PG8_WAIT_V(8); PG8_WAIT_L(0); PG8_BAR; PG8_MMA(0, 0, At, B0); PG8_MMA(0, 1, At, B1); PG8_BAR; PG8_SCHED;
            PG8_LDA(At, 0, 1); PG8_STAGE(PG8_SB(0, 0), b2, voffB); PG8_STAGE(PG8_SB(0, 1), b2 + hstep, voffB); PG8_STAGE(PG8_SA(0, 0), a2, voffA);
            PG8_WAIT_V(8); PG8_WAIT_L(0); PG8_BAR; PG8_MMA(1, 0, At, B0); PG8_MMA(1, 1, At, B1); PG8_BAR; PG8_SCHED;
            PG8_LDB(B0, 1, 0); PG8_LDB(B1, 1, 1); PG8_SCHED; PG8_LDA(At, 1, 0); PG8_STAGE(PG8_SA(0, 1), a2 + hstep, voffA);
            PG8_WAIT_V(8); PG8_WAIT_L(0); PG8_BAR; PG8_MMA(0, 0, At, B0); PG8_MMA(0, 1, At, B1); PG8_BAR; PG8_SCHED;
            PG8_LDA(At, 1, 1); PG8_STAGE(PG8_SB(1, 0), b3, voffB); PG8_STAGE(PG8_SB(1, 1), b3 + hstep, voffB); PG8_STAGE(PG8_SA(1, 0), a3, voffA);
            PG8_WAIT_V(8); PG8_WAIT_L(0); PG8_BAR; PG8_MMA(1, 0, At, B0); PG8_MMA(1, 1, At, B1); PG8_BAR; PG8_SCHED;
            } else {
            PG8_LDB(B0, 0, 0); PG8_SCHED; PG8_LDA(At, 0, 0); PG8_STAGE(PG8_SA(1, 1), a1 + hstep, voffA);
            PG8_WAIT_L(8); PG8_BAR; PG8_WAIT_L(0); PG8_MMA(0, 0, At, B0); PG8_BAR; PG8_SCHED;
            PG8_LDB(B1, 0, 1); PG8_STAGE(PG8_SB(0, 0), b2, voffB);
            PG8_BAR; PG8_WAIT_L(0); PG8_MMA(0, 1, At, B1); PG8_BAR;
            PG8_LDA(At, 0, 1); PG8_STAGE(PG8_SA(0, 0), a2, voffA);
            PG8_BAR; PG8_WAIT_L(0); PG8_MMA(1, 0, At, B0); PG8_BAR; PG8_SCHED;
            PG8_STAGE(PG8_SB(0, 1), b2 + hstep, voffB);
            PG8_WAIT_V(6); PG8_BAR; PG8_MMA(1, 1, At, B1); PG8_BAR;
            PG8_LDB(B0, 1, 0); PG8_SCHED; PG8_LDA(At, 1, 0); PG8_STAGE(PG8_SA(0, 1), a2 + hstep, voffA);
            PG8_WAIT_L(8); PG8_BAR; PG8_WAIT_L(0); PG8_MMA(0, 0, At, B0); PG8_BAR; PG8_SCHED;
            PG8_LDB(B1, 1, 1); PG8_STAGE(PG8_SB(1, 0), b3, voffB);
            PG8_BAR; PG8_WAIT_L(0); PG8_MMA(0, 1, At, B1); PG8_BAR;
            PG8_LDA(At, 1, 1); PG8_STAGE(PG8_SA(1, 0), a3, voffA);
            PG8_BAR; PG8_WAIT_L(0); PG8_MMA(1, 0, At, B0); PG8_BAR; PG8_SCHED;
            PG8_STAGE(PG8_SB(1, 1), b3 + hstep, voffB);
            PG8_WAIT_V(6); PG8_BAR; PG8_MMA(1, 1, At, B1); PG8_BAR;
            }
        }
        if constexpr (ALIGN_EPI) { if (wr == 0) PG8_BAR; }
        if constexpr (!Epi::AFTER_DRAIN) { E(acc, cur, wr, wc, fr, fq); S.done(cur); }
        if (!has_next) break;
#pragma unroll
        for (int a = 0; a < 2; ++a)
#pragma unroll
            for (int b = 0; b < 2; ++b)
#pragma unroll
                for (int m = 0; m < 4; ++m)
#pragma unroll
                    for (int n = 0; n < 2; ++n) acc[a][b][m][n] = (f32x4){0.f, 0.f, 0.f, 0.f};
        cur = nxt; cA = nA; cB = nB; ++ui;
        if constexpr (ALIGN_EPI) { if (wr == 1) PG8_BAR; }
    }
    PG8_WAIT_V(0);
    if constexpr (!ALIGN_EPI) { if (wr == 0) PG8_BAR; }
    PG8_BAR;
    if constexpr (Epi::AFTER_DRAIN) { E.fused(acc, cur, wr, wc, fr, fq, lds, wid, lane); S.done(cur); }
#undef PG8_SA
#undef PG8_SB
#undef PG8_STAGE
#undef PG8_LDA
#undef PG8_LDB
#undef PG8_MMA
#undef PG8_WAIT_V
#undef PG8_WAIT_L
#undef PG8_BAR
#undef PG8_SCHED
}
}

constexpr int BATCH = 8, SEQ = 2048, DM = 1024, M = BATCH * SEQ, NQKV = 3072, DFF = 2816, HFF = DFF / 2;
constexpr float NORM_EPS = 1e-6f, SUBLN_EPS = 1e-5f, LOG2E = 1.4426950408889634f;
constexpr int NWAVES = 8, NTHREADS = NWAVES * 64;
constexpr int LDS_BYTES = 147456;
constexpr int MISC_OFF = 131072 + 320;

#define LAS __attribute__((address_space(3)))
typedef unsigned short bf16;
typedef unsigned v4u __attribute__((ext_vector_type(4)));
typedef unsigned v2u __attribute__((ext_vector_type(2)));
typedef float f32x4 __attribute__((ext_vector_type(4)));
typedef float f32x16 __attribute__((ext_vector_type(16)));
typedef short bf16x8 __attribute__((ext_vector_type(8)));
typedef short s16x4 __attribute__((ext_vector_type(4)));

constexpr size_t MiB = 1u << 20;
constexpr size_t WS_WQKV = 1 * MiB;
constexpr size_t WS_WO = 7 * MiB;
constexpr size_t WS_UP0 = 9 * MiB, WS_UP1 = 20 * MiB;
constexpr size_t WS_DN0 = 31 * MiB, WS_DN1 = 36 * MiB + 512 * 1024;
constexpr size_t WS_XN = 42 * MiB;
constexpr size_t WS_BIG = 74 * MiB;
constexpr size_t WS_A2 = 168 * MiB;
constexpr size_t WS_END = 256 * MiB;

__device__ __forceinline__ unsigned f2bf(float f) { unsigned u = __builtin_bit_cast(unsigned, f); return (u + 0x7fffu + ((u >> 16) & 1u)) >> 16; }
__device__ __forceinline__ unsigned pk2(float lo, float hi) { return pg8::cvt_pk_bf16(lo, hi); }
__device__ __forceinline__ float bflo(unsigned w) { return __builtin_bit_cast(float, w << 16); }
__device__ __forceinline__ float bfhi(unsigned w) { return __builtin_bit_cast(float, w & 0xffff0000u); }
__device__ __forceinline__ float wave_sum(float v) {
#pragma unroll
    for (int o = 1; o < 64; o <<= 1) v += __shfl_xor(v, o);
    return v;
}

template <int MODE>
__device__ __forceinline__ void transpose_item(const float* __restrict__ W, int K, int N, bf16* __restrict__ WT, LAS float* scr, int item, int lane) {
    const int nblk = N / 32, kb = item / nblk, nb = item % nblk, k0 = 64 * kb, n0 = 32 * nb;
    int d0 = n0;
    if (MODE == 1) { const int isv = n0 >= DFF; const int c = isv ? n0 - DFF : n0; const int half = c / HFF, idx = c % HFF; d0 = half * (2 * HFF) + (isv ? HFF : 0) + idx; }
#pragma unroll 8
    for (int i = 0; i < 32; ++i) { const int kk = 2 * i + (lane >> 5); scr[kk * 33 + (lane & 31)] = W[(size_t)(k0 + kk) * N + n0 + (lane & 31)]; }
    asm volatile("s_waitcnt lgkmcnt(0)" ::: "memory");
    const int c = lane & 7;
#pragma unroll
    for (int j = 0; j < 4; ++j) { const int n = (lane >> 3) + 8 * j; const LAS float* s = scr + (8 * c) * 33 + n;
        v4u o; o.x = pk2(s[0 * 33], s[1 * 33]); o.y = pk2(s[2 * 33], s[3 * 33]); o.z = pk2(s[4 * 33], s[5 * 33]); o.w = pk2(s[6 * 33], s[7 * 33]);
        *(v4u*)(WT + (size_t)(d0 + n) * K + k0 + 8 * c) = o; }
    asm volatile("s_waitcnt lgkmcnt(0)" ::: "memory");
}

__device__ __forceinline__ void rms_row_to_bf16(const float* __restrict__ xrow, const float* __restrict__ g, bf16* __restrict__ orow, int lane) {
    const f32x4* xr = (const f32x4*)xrow + lane; const f32x4* gr = (const f32x4*)g + lane;
    f32x4 v[4]; float s = 0.f;
#pragma unroll
    for (int j = 0; j < 4; ++j) { v[j] = xr[64 * j]; s += (v[j].x * v[j].x + v[j].y * v[j].y) + (v[j].z * v[j].z + v[j].w * v[j].w); }
    const float rs = 1.0f / sqrtf(wave_sum(s) * (1.f / DM) + NORM_EPS);
    v2u* o8 = (v2u*)orow + lane;
#pragma unroll
    for (int j = 0; j < 4; ++j) { const f32x4 gg = gr[64 * j]; v2u w; w.x = pk2(v[j].x * rs * gg.x, v[j].y * rs * gg.y); w.y = pk2(v[j].z * rs * gg.z, v[j].w * rs * gg.w); o8[64 * j] = w; }
}

__device__ __forceinline__ void rowwise_phase(int gw, int NGW, int lane, const float* __restrict__ MF, const float* Xin, float* Xout, const float* __restrict__ gA, const float* __restrict__ gB, bf16* __restrict__ XN) {
    for (int m = gw; m < M; m += NGW) {
        const f32x4* mr = (const f32x4*)(MF + (size_t)m * DM) + lane; const f32x4* xr = (const f32x4*)(Xin + (size_t)m * DM) + lane;
        f32x4 mv[4], xv[4]; float s = 0.f;
#pragma unroll
        for (int j = 0; j < 4; ++j) { mv[j] = mr[64 * j]; xv[j] = xr[64 * j]; s += (mv[j].x * mv[j].x + mv[j].y * mv[j].y) + (mv[j].z * mv[j].z + mv[j].w * mv[j].w); }
        const float rs = 1.0f / sqrtf(wave_sum(s) * (1.f / DM) + NORM_EPS);
        f32x4* xo = (f32x4*)(Xout + (size_t)m * DM) + lane; float s2 = 0.f;
#pragma unroll
        for (int j = 0; j < 4; ++j) { const f32x4 ga = ((const f32x4*)gA + lane)[64 * j]; xv[j] = xv[j] + mv[j] * rs * ga; xo[64 * j] = xv[j];
            s2 += (xv[j].x * xv[j].x + xv[j].y * xv[j].y) + (xv[j].z * xv[j].z + xv[j].w * xv[j].w); }
        if (XN) {
            const float rs2 = 1.0f / sqrtf(wave_sum(s2) * (1.f / DM) + NORM_EPS);
            v2u* o8 = (v2u*)(XN + (size_t)m * DM) + lane;
#pragma unroll
            for (int j = 0; j < 4; ++j) { const f32x4 gb = ((const f32x4*)gB + lane)[64 * j]; v2u w; w.x = pk2(xv[j].x * rs2 * gb.x, xv[j].y * rs2 * gb.y); w.y = pk2(xv[j].z * rs2 * gb.z, xv[j].w * rs2 * gb.w); o8[64 * j] = w; }
        }
    }
}

__device__ __forceinline__ void unpack8(const v4u w, float (&f)[8]) {
    f[0] = bflo(w.x); f[1] = bfhi(w.x); f[2] = bflo(w.y); f[3] = bfhi(w.y); f[4] = bflo(w.z); f[5] = bfhi(w.z); f[6] = bflo(w.w); f[7] = bfhi(w.w);
}
__device__ __forceinline__ v4u pack8(const float (&f)[8]) { v4u o; o.x = pk2(f[0], f[1]); o.y = pk2(f[2], f[3]); o.z = pk2(f[4], f[5]); o.w = pk2(f[6], f[7]); return o; }
__device__ __forceinline__ void load8f(const float* p, float (&f)[8]) { const f32x4 a = *(const f32x4*)p, b = *(const f32x4*)(p + 4); f[0] = a.x; f[1] = a.y; f[2] = a.z; f[3] = a.w; f[4] = b.x; f[5] = b.y; f[6] = b.z; f[7] = b.w; }

__device__ __forceinline__ void convmix_phase(int gtid, int nthr, const bf16* __restrict__ BCH, const float* __restrict__ cw, bf16* __restrict__ Y) {
    constexpr int RB = 16, NITEMS = 128 * (M / RB);
    for (int it = gtid; it < NITEMS; it += nthr) {
        const int grp = it & 127, rb = it >> 7, ch = grp * 8, row0 = rb * RB, s0 = row0 & (SEQ - 1);
        float w0[8], w1[8], w2[8]; load8f(cw + ch, w0); load8f(cw + DM + ch, w1); load8f(cw + 2 * DM + ch, w2);
        float p2[8], p1[8];
#pragma unroll
        for (int k = 0; k < 8; ++k) { p2[k] = 0.f; p1[k] = 0.f; }
        if (s0 > 0) {
            const bf16* r2 = BCH + (size_t)(row0 - 2) * NQKV + ch; float c[8], hv[8];
            unpack8(*(const v4u*)(r2 + 1024), c); unpack8(*(const v4u*)(r2 + 2048), hv);
#pragma unroll
            for (int k = 0; k < 8; ++k) p2[k] = c[k] * hv[k];
            unpack8(*(const v4u*)(r2 + NQKV + 1024), c); unpack8(*(const v4u*)(r2 + NQKV + 2048), hv);
#pragma unroll
            for (int k = 0; k < 8; ++k) p1[k] = c[k] * hv[k];
        }
#pragma unroll 4
        for (int r = 0; r < RB; ++r) {
            const bf16* rp = BCH + (size_t)(row0 + r) * NQKV + ch; float b[8], c[8], hv[8], y[8];
            unpack8(*(const v4u*)rp, b); unpack8(*(const v4u*)(rp + 1024), c); unpack8(*(const v4u*)(rp + 2048), hv);
#pragma unroll
            for (int k = 0; k < 8; ++k) { const float p0 = c[k] * hv[k]; y[k] = b[k] * (w0[k] * p2[k] + w1[k] * p1[k] + w2[k] * p0); p2[k] = p1[k]; p1[k] = p0; }
            *(v4u*)(Y + (size_t)(row0 + r) * DM + ch) = pack8(y);
        }
    }
}

__device__ __forceinline__ void convffn_phase(int gtid, int nthr, const bf16* __restrict__ U, const float* __restrict__ cw, bf16* __restrict__ A2, int hf) {
    constexpr int RB = 16, NG = HFF / 8, NITEMS = NG * (M / RB);
    for (int it = gtid; it < NITEMS; it += nthr) {
        const int grp = it % NG, rb = it / NG, idx = grp * 8, chg = hf * HFF + idx, row0 = rb * RB, s0 = row0 & (SEQ - 1);
        float wg0[8], wg1[8], wg2[8], wv0[8], wv1[8], wv2[8];
        load8f(cw + chg, wg0); load8f(cw + 2 * DFF + chg, wg1); load8f(cw + 4 * DFF + chg, wg2);
        load8f(cw + DFF + chg, wv0); load8f(cw + 3 * DFF + chg, wv1); load8f(cw + 5 * DFF + chg, wv2);
        float g2[8], g1[8], v2[8], v1[8];
#pragma unroll
        for (int k = 0; k < 8; ++k) { g2[k] = 0.f; g1[k] = 0.f; v2[k] = 0.f; v1[k] = 0.f; }
        if (s0 > 0) {
            const bf16* r2 = U + (size_t)(row0 - 2) * DFF + idx;
            unpack8(*(const v4u*)r2, g2); unpack8(*(const v4u*)(r2 + HFF), v2);
            unpack8(*(const v4u*)(r2 + DFF), g1); unpack8(*(const v4u*)(r2 + DFF + HFF), v1);
        }
#pragma unroll 4
        for (int r = 0; r < RB; ++r) {
            const bf16* rp = U + (size_t)(row0 + r) * DFF + idx; float g0[8], v0[8], y[8];
            unpack8(*(const v4u*)rp, g0); unpack8(*(const v4u*)(rp + HFF), v0);
#pragma unroll
            for (int k = 0; k < 8; ++k) {
                const float G = wg0[k] * g2[k] + wg1[k] * g1[k] + wg2[k] * g0[k];
                const float V = wv0[k] * v2[k] + wv1[k] * v1[k] + wv2[k] * v0[k];
                const float e = __builtin_amdgcn_exp2f(-G * LOG2E);
                y[k] = G * __builtin_amdgcn_rcpf(1.0f + e) * V;
                g2[k] = g1[k]; g1[k] = g0[k]; v2[k] = v1[k]; v1[k] = v0[k];
            }
            *(v4u*)(A2 + (size_t)(row0 + r) * DFF + chg) = pack8(y);
        }
    }
}

namespace att {
typedef LAS const char* lcp;
typedef float f32x2_t __attribute__((ext_vector_type(2))); typedef __bf16 bf16x2_t __attribute__((ext_vector_type(2)));
__device__ __forceinline__ unsigned cvtpk(float lo, float hi) { f32x2_t v = {lo, hi}; bf16x2_t b = __builtin_convertvector(v, bf16x2_t); return __builtin_bit_cast(unsigned, b); }
__device__ __forceinline__ s16x4 vtr(lcp p) { return __builtin_bit_cast(s16x4, __builtin_amdgcn_ds_read_tr16_b64_v4i16((LAS s16x4*)p)); }
__device__ __forceinline__ float xhalf_max(float v) { auto rr = __builtin_amdgcn_permlane32_swap(__float_as_uint(v), __float_as_uint(v), false, false); return fmaxf(__uint_as_float(rr[0]), __uint_as_float(rr[1])); }
__device__ __forceinline__ float xhalf_sum(float v) { auto rr = __builtin_amdgcn_permlane32_swap(__float_as_uint(v), __float_as_uint(v), false, false); return __uint_as_float(rr[0]) + __uint_as_float(rr[1]); }
__device__ __forceinline__ void glds16(const void* gsrc, unsigned lds_dst) { unsigned keep;
    asm volatile("s_mov_b32 %0, m0\n\ts_mov_b32 m0, %2\n\ts_nop 0\n\tglobal_load_lds_dwordx4 %1, off\n\ts_mov_b32 m0, %0" : "=&s"(keep) : "v"(gsrc), "s"(lds_dst) : "memory"); }
constexpr int TILE_BYTES = 32768, K1_OFF = 0, K2_OFF = 8192, V_OFF = 16384, Q_OFF = 2 * TILE_BYTES;

__device__ __forceinline__ void attn_map(f32x16 (&o)[4], float& m, float& l, lcp qb, lcp kb, lcp vp, float dbase, float nslope) {
    f32x16 p0, p1;
#pragma unroll
    for (int r = 0; r < 16; ++r) { p0[r] = 0.f; p1[r] = 0.f; }
    __builtin_amdgcn_sched_barrier(0);
#pragma unroll
    for (int d0 = 0; d0 < 4; ++d0) {
        const bf16x8 qf = *(const LAS bf16x8*)(qb + d0 * 1024);
        const bf16x8 a0 = *(const LAS bf16x8*)(kb + d0 * 2048), a1 = *(const LAS bf16x8*)(kb + d0 * 2048 + 512);
        p0 = __builtin_amdgcn_mfma_f32_32x32x16_bf16(a0, qf, p0, 0, 0, 0);
        p1 = __builtin_amdgcn_mfma_f32_32x32x16_bf16(a1, qf, p1, 0, 0, 0);
    }
    __builtin_amdgcn_sched_barrier(0);
    float rm = -INFINITY;
#pragma unroll
    for (int g = 0; g < 4; ++g) {
#pragma unroll
        for (int i = 0; i < 4; ++i) { const int r = 4 * g + i; const float c = (float)((r & 3) + 8 * (r >> 2));
            p0[r] = fmaf(nslope, fabsf(dbase - c), p0[r]); p1[r] = fmaf(nslope, fabsf(dbase - 32.f - c), p1[r]);
            rm = fmaxf(rm, fmaxf(p0[r], p1[r])); }
        __builtin_amdgcn_sched_barrier(0);
    }
    rm = xhalf_max(rm);
    const float mn = fmaxf(m, rm), alpha = __builtin_amdgcn_exp2f(m - mn); m = mn;
    float s = 0.f;
    v4u pw[4];
    __builtin_amdgcn_sched_barrier(0);
#pragma unroll
    for (int g = 0; g < 4; ++g) {
        float e[8];
#pragma unroll
        for (int i = 0; i < 8; ++i) { e[i] = __builtin_amdgcn_exp2f(((g < 2) ? p0[(g & 1) * 8 + i] : p1[(g & 1) * 8 + i]) - mn); }
        s += ((e[0] + e[1]) + (e[2] + e[3])) + ((e[4] + e[5]) + (e[6] + e[7]));
        pw[g] = (v4u){cvtpk(e[0], e[1]), cvtpk(e[2], e[3]), cvtpk(e[4], e[5]), cvtpk(e[6], e[7])};
        __builtin_amdgcn_sched_barrier(0);
    }
    l = l * alpha + s;
#pragma unroll
    for (int d0 = 0; d0 < 4; ++d0) o[d0] = o[d0] * alpha;
    __builtin_amdgcn_sched_barrier(0);
#pragma unroll
    for (int d0 = 0; d0 < 4; ++d0) {
#pragma unroll
        for (int ks = 0; ks < 4; ++ks) {
            const s16x4 lo = vtr(vp + (d0 * 4 + ks) * 1024), hh = vtr(vp + (d0 * 4 + ks) * 1024 + 512);
            const bf16x8 vf = (bf16x8){lo[0], lo[1], lo[2], lo[3], hh[0], hh[1], hh[2], hh[3]};
            o[d0] = __builtin_amdgcn_mfma_f32_32x32x16_bf16(vf, __builtin_bit_cast(bf16x8, pw[ks]), o[d0], 0, 0, 0);
        }
        __builtin_amdgcn_sched_barrier(0);
    }
}

__device__ __forceinline__ void attn_unit(const bf16* QKV, bf16* O, int b, int h, int u, LAS char* lds, float lam, float oscale, const float* sg) {
    int tid = threadIdx.x; asm volatile("" : "+v"(tid));
    asm volatile("" : "+s"(QKV), "+s"(O), "+s"(sg));
    const int lane = tid & 63, r32 = lane & 31, hi = lane >> 5; const int wid = __builtin_amdgcn_readfirstlane(tid >> 6);
    const size_t rowbase = (size_t)b * SEQ; const int qpos = u * 256 + wid * 32 + r32;
    const bf16* qp = QKV + (rowbase + qpos) * NQKV + h * 64 + hi * 8;
    LAS char* qlds = lds + Q_OFF + wid * 8192 + hi * 512 + r32 * 16;
#pragma unroll
    for (int d0 = 0; d0 < 4; ++d0) { *(LAS bf16x8*)(qlds + d0 * 1024) = *(const bf16x8*)(qp + d0 * 16); *(LAS bf16x8*)(qlds + 4096 + d0 * 1024) = *(const bf16x8*)(qp + 512 + d0 * 16); }
    const int NT = 4 * u + 4, my_nt = 4 * u + (wid >> 1) + 1;
    const bf16* ksrc = QKV + (rowbase + lane) * NQKV + 1024 + h * 64 + wid * 8;
    const bf16* vsrc = QKV + (rowbase + 16 * ((2 * wid) & 3) + (lane >> 2)) * NQKV + 2048 + h * 128 + ((2 * wid) >> 2) * 32 + (lane & 3) * 8;
    const unsigned lds0 = (unsigned)(uintptr_t)lds;
    const float nslope = -exp2f(-(float)(h + 1)) * LOG2E;
#define ATT_DMA(t, buf) do { const size_t go = (size_t)(t) * 64 * NQKV; const unsigned bb_ = (unsigned)__builtin_amdgcn_readfirstlane(lds0 + (buf) * TILE_BYTES + wid * 1024); \
        glds16(ksrc + go, bb_ + K1_OFF); glds16(ksrc + go + 512, bb_ + K2_OFF); glds16(vsrc + go, bb_ + V_OFF + wid * 1024); glds16(vsrc + go + (size_t)16 * NQKV, bb_ + V_OFF + wid * 1024 + 1024); } while (0)
    f32x16 o1[4], o2[4];
#pragma unroll
    for (int d0 = 0; d0 < 4; ++d0)
#pragma unroll
        for (int r = 0; r < 16; ++r) { o1[d0][r] = 0.f; o2[d0][r] = 0.f; }
    float m1 = -INFINITY, m2 = -INFINITY, l1 = 0.f, l2 = 0.f;
    ATT_DMA(0, 0);
    asm volatile("s_waitcnt vmcnt(0) lgkmcnt(0)" ::: "memory");
    __syncthreads();
    const int koff = hi * 1024 + r32 * 16;
    const int voff = V_OFF + ((lane >> 4) & 1) * 32 + (lane & 3) * 8 + (4 * hi + ((lane & 15) >> 2)) * 64;
    for (int t = 0; t < NT; ++t) {
        if (t + 1 < NT) ATT_DMA(t + 1, (t + 1) & 1);
        if (t < my_nt) {
            lcp bb = (lcp)(lds + (t & 1) * TILE_BYTES);
            const float dbase = (float)(qpos - 64 * t - 4 * hi);
            attn_map(o1, m1, l1, (lcp)qlds, bb + K1_OFF + koff, bb + voff, dbase, nslope);
            attn_map(o2, m2, l2, (lcp)qlds + 4096, bb + K2_OFF + koff, bb + voff, dbase, nslope);
        }
        asm volatile("s_waitcnt vmcnt(0) lgkmcnt(0)" ::: "memory");
        __syncthreads();
    }
#undef ATT_DMA
    l1 = xhalf_sum(l1); l2 = xhalf_sum(l2);
    int tid2 = threadIdx.x; asm volatile("" : "+v"(tid2));
    const int hi2 = (tid2 >> 5) & 1, qpos2 = u * 256 + wid * 32 + (tid2 & 31);
    const float i1 = 1.0f / l1, i2 = lam / l2; float ss = 0.f;
#pragma unroll
    for (int d0 = 0; d0 < 4; ++d0)
#pragma unroll
        for (int r = 0; r < 16; ++r) { const float v = o1[d0][r] * i1 - o2[d0][r] * i2; o1[d0][r] = v; ss += v * v; }
    ss = xhalf_sum(ss);
    const float rs = oscale / sqrtf(ss * (1.f / 128.f) + SUBLN_EPS);
    bf16* op = O + (rowbase + qpos2) * DM + h * 128 + 4 * hi2;
#pragma unroll
    for (int d0 = 0; d0 < 4; ++d0)
#pragma unroll
        for (int g4 = 0; g4 < 4; ++g4) { const int v0 = 32 * d0 + 8 * g4; const f32x4 gg = *(const f32x4*)(sg + v0 + 4 * hi2);
            v2u w; w.x = pk2(o1[d0][4 * g4] * rs * gg.x, o1[d0][4 * g4 + 1] * rs * gg.y); w.y = pk2(o1[d0][4 * g4 + 2] * rs * gg.z, o1[d0][4 * g4 + 3] * rs * gg.w);
            *(v2u*)(op + v0) = w; }
}
}

#define XB_TMO      128
#define XB_XCNT(j)  (256  + 64 * (j))
#define XB_XSUB(j)  (1280 + 64 * (j))
#define XB_XGEN(j)  (2304 + 64 * (j))
#define XB_TOP      3328
#define XB_TOPGEN   3392
#define XCD_BAR_WORDS 3456
#define XB_SPIN_CAP (1u << 18)

__device__ __forceinline__ unsigned xb_ld(unsigned* p)              { return __hip_atomic_load(p, __ATOMIC_RELAXED, __HIP_MEMORY_SCOPE_AGENT); }
__device__ __forceinline__ unsigned xb_add(unsigned* p, unsigned v) { return __hip_atomic_fetch_add(p, v, __ATOMIC_RELAXED, __HIP_MEMORY_SCOPE_AGENT); }
__device__ __forceinline__ unsigned xb_xcc_id() { return (unsigned)__builtin_amdgcn_s_getreg((3 << 11) | 20) & 0xFu; }
#define XB_SPIN(cond, bar) do { unsigned _sp = 0; while (cond) { __builtin_amdgcn_s_sleep(1); \
    if ((++_sp & 255u) == 0u) { if (xb_ld(&(bar)[XB_TMO])) break; if (_sp > XB_SPIN_CAP) { atomicAdd(&(bar)[XB_TMO], 1u); break; } } } } while (0)

struct XcdBarrier {
    unsigned* bar; unsigned x;
    volatile LAS unsigned* st;
};

__device__ __forceinline__ XcdBarrier xcd_barrier_post(unsigned* bar, volatile LAS unsigned* st) {
    XcdBarrier b; b.bar = bar; b.x = xb_xcc_id(); b.st = st;
    if (threadIdx.x == 0) (void)xb_add(&bar[XB_XCNT(b.x)], 1u);
    return b;
}
__device__ __forceinline__ void xcd_barrier_complete(unsigned* bar, unsigned x, unsigned& nloc, unsigned& nx) {
    const unsigned G = gridDim.x * gridDim.y * gridDim.z;
    unsigned sum, cnt, mine, sp = 0u;
    for (;;) {
        sum = 0u; cnt = 0u; mine = 0u;
#pragma unroll
        for (unsigned j = 0; j < 16; ++j) { const unsigned c = xb_ld(&bar[XB_XCNT(j)]); sum += c; cnt += (c > 0u) ? 1u : 0u; mine = (j == x) ? c : mine; }
        if (sum == G) break;
        __builtin_amdgcn_s_sleep(1);
        if ((++sp & 255u) == 0u) { if (xb_ld(&bar[XB_TMO])) break; if (sp > XB_SPIN_CAP) { atomicAdd(&bar[XB_TMO], 1u); break; } }
    }
    nloc = mine > 0u ? mine : 1u; nx = cnt > 0u ? cnt : 1u;
}

__device__ __forceinline__ void xcd_barrier(const XcdBarrier& b) {
    asm volatile("s_waitcnt vmcnt(0)" ::: "memory");
    __syncthreads();
    if (threadIdx.x == 0) {
        unsigned* bar = b.bar;
        __builtin_amdgcn_s_waitcnt(0);
        unsigned nloc = b.st[0], nx = b.st[1];
        if (nloc == 0u) { xcd_barrier_complete(bar, b.x, nloc, nx); b.st[0] = nloc; b.st[1] = nx; }
        const unsigned old = xb_add(&bar[XB_XSUB(b.x)], 1u);
        const unsigned gen = old / nloc;
        if (old + 1u == (gen + 1u) * nloc) {
            __builtin_amdgcn_fence(__ATOMIC_RELEASE, "agent");
            asm volatile("s_waitcnt vmcnt(0)" ::: "memory");
            const unsigned og = xb_add(&bar[XB_TOP], 1u);
            const unsigned tg = og / nx;
            if (og + 1u == (tg + 1u) * nx) xb_add(&bar[XB_TOPGEN], 1u);
            else XB_SPIN(xb_ld(&bar[XB_TOPGEN]) == tg, bar);
            __builtin_amdgcn_fence(__ATOMIC_ACQUIRE, "agent");
            xb_add(&bar[XB_XGEN(b.x)], 1u);
            asm volatile("s_waitcnt vmcnt(0)" ::: "memory");
        } else {
            XB_SPIN(xb_ld(&bar[XB_XGEN(b.x)]) == gen, bar);
            __builtin_amdgcn_fence(__ATOMIC_ACQUIRE, "agent");
            asm volatile("s_waitcnt vmcnt(0)" ::: "memory");
        }
    }
    __syncthreads();
}

struct Args { const float* in[15]; float* out; unsigned char* ws; int ph_lo, ph_hi; };
enum { IN_X = 0, IN_NG, IN_WQKV, IN_WO, IN_LQ1, IN_LK1, IN_LQ2, IN_LK2, IN_SG, IN_WIN, IN_CW, IN_WOUT, IN_WUP, IN_FCW, IN_WDN };
constexpr int NPHASES = 21;

template <int ph>
__device__ __forceinline__ void run_phase(const Args& a, LAS unsigned char* lds) {
    const int tid = threadIdx.x, lane = tid & 63, wave = __builtin_amdgcn_readfirstlane(tid >> 6);
    const int G = gridDim.x, bx = blockIdx.x;
    const int vcu = (G % 8 == 0) ? (bx % 8) * (G / 8) + bx / 8 : bx;
    const int gw = vcu * NWAVES + wave, NGW = G * NWAVES, gtid = vcu * NTHREADS + tid, nthr = G * NTHREADS;
    unsigned char* ws = a.ws;
    bf16* const XN = (bf16*)(ws + WS_XN); bf16* const BIG = (bf16*)(ws + WS_BIG); float* const MF = (float*)(ws + WS_BIG); bf16* const A2 = (bf16*)(ws + WS_A2);
    bf16* const WQKV = (bf16*)(ws + WS_WQKV); bf16* const WO = (bf16*)(ws + WS_WO);
    const float* ng = a.in[IN_NG];
    LAS float* scr = (LAS float*)(lds + wave * 16384);
    (void)gw; (void)NGW; (void)gtid; (void)nthr; (void)XN; (void)BIG; (void)MF; (void)A2; (void)WQKV; (void)WO; (void)ng; (void)scr; (void)lane;
    {
        constexpr int L = (ph >= 11) ? 1 : 0, lp = ph - 10 * L;
        if constexpr (ph == 0) {
            constexpr int I_QKV = 16 * 96, I_O = 16 * 32, I_UP = 16 * 176, I_DN = 44 * 32, NIT = I_QKV + I_O + 2 * I_UP + 2 * I_DN;
            for (int it = gw; it < NIT; it += NGW) {
                int r = it;
                if (r < I_QKV) { transpose_item<0>(a.in[IN_WQKV], 1024, 3072, WQKV, scr, r, lane); continue; } r -= I_QKV;
                if (r < I_O) { transpose_item<0>(a.in[IN_WO], 1024, 1024, WO, scr, r, lane); continue; } r -= I_O;
                if (r < I_UP) { transpose_item<1>(a.in[IN_WUP], 1024, 2 * DFF, (bf16*)(ws + WS_UP0), scr, r, lane); continue; } r -= I_UP;
                if (r < I_UP) { transpose_item<1>(a.in[IN_WUP] + (size_t)1024 * 2 * DFF, 1024, 2 * DFF, (bf16*)(ws + WS_UP1), scr, r, lane); continue; } r -= I_UP;
                if (r < I_DN) { transpose_item<0>(a.in[IN_WDN], DFF, 1024, (bf16*)(ws + WS_DN0), scr, r, lane); continue; } r -= I_DN;
                transpose_item<0>(a.in[IN_WDN] + (size_t)DFF * 1024, DFF, 1024, (bf16*)(ws + WS_DN1), scr, r, lane);
            }
            for (int m = gw; m < M; m += NGW) rms_row_to_bf16(a.in[IN_X] + (size_t)m * DM, ng, XN + (size_t)m * DM, lane);
        } else if constexpr (lp == 1) {
            pg8::Gemm g{XN, WQKV, M, NQKV, DM}; pg8::StaticOrder S; S.init(M, NQKV, G, bx);
            pg8::EpiBf16 E{BIG, NQKV, (L == 0) ? 1024 : 0, 0.125f * LOG2E};
#if !defined(NO_GEMM) && !defined(NO_GEMM_BF)
            pg8::gemm_phase<pg8::EpiBf16, pg8::StaticOrder, true, true>(lds, g, S, E);
#endif
        } else if constexpr (lp == 5 || lp == 7) {
            const bf16* Bt = (bf16*)(ws + (L ? WS_UP1 : WS_UP0)) + (size_t)(lp == 7) * DFF * DM;
            pg8::Gemm g{XN, Bt, M, DFF, DM}; pg8::StaticOrder S; S.init(M, DFF, G, bx);
            pg8::EpiBf16 E{BIG, DFF, 0, 1.f};
#if !defined(NO_GEMM) && !defined(NO_GEMM_BF)
            pg8::gemm_phase<pg8::EpiBf16, pg8::StaticOrder, true, true>(lds, g, S, E);
#endif
        } else if constexpr (lp == 2) {
            if constexpr (L == 0) {
                float s1 = 0.f, s2 = 0.f;
                for (int i = 0; i < 64; ++i) { s1 += a.in[IN_LQ1][i] * a.in[IN_LK1][i]; s2 += a.in[IN_LQ2][i] * a.in[IN_LK2][i]; }
                const float lam_init = 0.2f, lam = expf(s1) - expf(s2) + lam_init;
#ifndef NO_ATTN
                for (int pi = vcu; pi < 256; pi += G) {
                    const int bh = pi >> 2, s = pi & 3;
#pragma nounroll
                    for (int k = 0; k < 2; ++k)
                        att::attn_unit(BIG, XN, bh >> 3, bh & 7, k ? 7 - s : s, (LAS char*)lds, lam, 1.0f - lam_init, a.in[IN_SG]);
                }
#endif
            } else {
                convmix_phase(gtid, nthr, BIG, a.in[IN_CW], XN);
            }
        } else if constexpr (lp == 3) {
            pg8::Gemm g{XN, WO, M, DM, DM}; pg8::StaticOrder S; S.init(M, DM, G, bx);
            pg8::EpiF32 E{MF, DM};
#if !defined(NO_GEMM) && !defined(NO_GEMM_F32)
            pg8::gemm_phase<pg8::EpiF32, pg8::StaticOrder, true, true>(lds, g, S, E);
#endif
        } else if constexpr (lp == 9) {
            pg8::Gemm g{A2, (bf16*)(ws + (L ? WS_DN1 : WS_DN0)), M, DM, DFF}; pg8::StaticOrder S; S.init(M, DM, G, bx);
            pg8::EpiF32 E{MF, DM};
#if !defined(NO_GEMM) && !defined(NO_GEMM_F32)
            pg8::gemm_phase<pg8::EpiF32, pg8::StaticOrder, true, true>(lds, g, S, E);
#endif
        } else if constexpr (lp == 4 || lp == 10) {
            const float* gA = ng + (size_t)(L * 4 + (lp == 4 ? 1 : 3)) * DM;
            const float* gB = (lp == 4) ? ng + (size_t)(L * 4 + 2) * DM : ng + (size_t)4 * DM;
            const float* Xin = (L == 0 && lp == 4) ? a.in[IN_X] : a.out;
            bf16* xn = (L == 1 && lp == 10) ? (bf16*)nullptr : XN;
            if (L == 0 && lp == 4) {
                constexpr int I_IN = 16 * 96, I_OUT = 16 * 32;
                for (int it = gw; it < I_IN + I_OUT; it += NGW) {
                    if (it < I_IN) transpose_item<0>(a.in[IN_WIN], 1024, 3072, WQKV, scr, it, lane);
                    else transpose_item<0>(a.in[IN_WOUT], 1024, 1024, WO, scr, it - I_IN, lane);
                }
            }
            rowwise_phase(gw, NGW, lane, MF, Xin, a.out, gA, gB, xn);
        } else {
            convffn_phase(gtid, nthr, BIG, a.in[IN_FCW] + (size_t)L * 3 * 2 * DFF, A2, lp == 8);
        }
    }
}

__global__ void __launch_bounds__(NTHREADS, 2) fwd(Args a) {
    extern __shared__ __attribute__((aligned(16))) unsigned char lds_raw[];
    LAS unsigned char* lds = (LAS unsigned char*)lds_raw;
    cg::grid_group grid = cg::this_grid();
    volatile LAS unsigned* MISC = (volatile LAS unsigned*)(lds + MISC_OFF);
    if (threadIdx.x < 32) MISC[threadIdx.x] = 0u;
    __syncthreads();
    XcdBarrier bar = xcd_barrier_post((unsigned*)a.ws, MISC + 8);
    if (a.ph_hi > NPHASES) grid.sync();
#define RUN(k) if (a.ph_lo <= (k) && (k) < a.ph_hi) { run_phase<k>(a, lds); if ((k) + 1 < a.ph_hi) xcd_barrier(bar); }
    RUN(0) RUN(1) RUN(2) RUN(3) RUN(4) RUN(5) RUN(6) RUN(7) RUN(8) RUN(9) RUN(10)
    RUN(11) RUN(12) RUN(13) RUN(14) RUN(15) RUN(16) RUN(17) RUN(18) RUN(19) RUN(20)
#undef RUN
}

extern "C" void kernel_launch(void* const* d_in, const int* in_sizes, int n_in, void* d_out, int out_size, void* d_ws, size_t ws_size, hipStream_t stream) {
    static int grid = 0;
    if (grid == 0) {
        if (n_in != 15 || in_sizes[0] != M * DM || out_size != M * DM || ws_size < WS_END) { fprintf(stderr, "kernel_launch: unexpected shapes (n_in %d, in0 %d, out %d, ws %zu)\n", n_in, n_in > 0 ? in_sizes[0] : -1, out_size, ws_size); grid = -1; return; }
        int dev = 0, cus = 0, per_cu = 0;
        hipGetDevice(&dev); hipDeviceGetAttribute(&cus, hipDeviceAttributeMultiprocessorCount, dev);
        if (hipFuncSetAttribute((const void*)fwd, hipFuncAttributeMaxDynamicSharedMemorySize, LDS_BYTES) != hipSuccess) { fprintf(stderr, "kernel_launch: hipFuncSetAttribute failed\n"); grid = -1; return; }
        if (hipOccupancyMaxActiveBlocksPerMultiprocessor(&per_cu, (const void*)fwd, NTHREADS, LDS_BYTES) != hipSuccess || per_cu < 1) { fprintf(stderr, "kernel_launch: occupancy query gave %d\n", per_cu); per_cu = 1; }
        (void)hipGetLastError();
        grid = cus * per_cu;
        fprintf(stderr, "kernel_launch: grid %d (cus %d x %d)\n", grid, cus, per_cu);
    }
    if (grid < 0) return;
    if (hipMemsetAsync(d_ws, 0, 16384, stream) != hipSuccess) { fprintf(stderr, "kernel_launch: memset of the barrier words failed\n"); return; }
    Args a{};
    for (int i = 0; i < 15; ++i) a.in[i] = (const float*)d_in[i];
    a.out = (float*)d_out; a.ws = (unsigned char*)d_ws;
#if defined(MULTI_LAUNCH)
    for (int ph = 0; ph < NPHASES; ++ph) { a.ph_lo = ph; a.ph_hi = ph + 1; hipLaunchKernelGGL(fwd, dim3(grid), dim3(NTHREADS), LDS_BYTES, stream, a); }
#else
    a.ph_lo = 0; a.ph_hi = NPHASES;
    void* args[] = {&a};
    hipError_t e = hipLaunchCooperativeKernel((const void*)fwd, dim3(grid), dim3(NTHREADS), args, LDS_BYTES, stream);
    if (e != hipSuccess) fprintf(stderr, "kernel_launch: cooperative launch failed: %s (grid %d)\n", hipGetErrorString(e), grid);
#endif
}
```
